# Optimizing an MI355X kernel written in HIP

```python
import jax, jax.numpy as jnp
from jax import lax
import numpy as np

D_MODEL = 1024
BATCH = 4
SEQ = 8192
DEPTH = 1

EPS = 1e-6
NEG_INF = -1e30
SGU_CHUNK = 128
SGU_GROUPS = 8
SGU_GROUP_DIM = 128
SGU_WIDTH = SGU_GROUPS * SGU_GROUP_DIM
ATT_HEADS = 8
ATT_HEAD_DIM = 64
ATT_PATTERNS = ((128, 1), (512, 4), (2048, 16))
ATT_GROUPS = len(ATT_PATTERNS)
ATT_Q_WIDTH = ATT_GROUPS * ATT_HEADS * ATT_HEAD_DIM
ATT_KV_WIDTH = ATT_HEADS * ATT_HEAD_DIM
N_BRANCHES = 2
IN_SPLITS = (SGU_WIDTH, SGU_WIDTH, ATT_Q_WIDTH, ATT_KV_WIDTH, ATT_KV_WIDTH, D_MODEL, D_MODEL)
IN_WIDTH = sum(IN_SPLITS)
PEER_HEADS = 8
PEER_N_KEYS = 128
PEER_N_EXPERTS = PEER_N_KEYS * PEER_N_KEYS
PEER_KEY_DIM = 256
PEER_HALF = PEER_KEY_DIM // 2
PEER_TOPK = 16
PEER_TOKEN_BLOCK = 128

kernel_name = 'hybrid_sgu_dilated_attn_peer_block'


def rmsnorm(x, g):
    xf = x.astype(jnp.float32)
    y = xf * lax.rsqrt(jnp.mean(xf * xf, axis=-1, keepdims=True) + EPS) * g.astype(jnp.float32)
    return y.astype(x.dtype)


def alibi_slopes(n_heads):
    return 2.0 ** (-8.0 * jnp.arange(1, n_heads + 1, dtype=jnp.float32) / n_heads)


def spatial_gating_mixer(z, norm_g, w_s, b_s):
    B, S, _ = z.shape
    u, v = jnp.split(z, 2, axis=-1)
    v = rmsnorm(v, norm_g).reshape(B, S // SGU_CHUNK, SGU_CHUNK, SGU_GROUPS, SGU_GROUP_DIM)
    v = jnp.einsum('gts,bnsgc->bntgc', w_s, v) + b_s.T[None, None, :, :, None]
    return u * v.reshape(B, S, SGU_WIDTH)


def dilated_band_attention(q, k, v, dilation, n_side, slopes):
    B, S, H, E = q.shape
    span = dilation * n_side
    Sp = -(-S // span) * span
    pad = [(0, 0), (0, Sp - S), (0, 0), (0, 0)]
    q, k, v = (jnp.pad(t.astype(jnp.float32), pad) for t in (q, k, v))
    M = Sp // dilation
    nb = M // n_side
    qb = q.reshape(B, nb, n_side, dilation, H, E)

    def windows(t):
        t = t.reshape(B, M, dilation, H, E)
        t = jnp.pad(t, [(0, 0), (n_side, n_side), (0, 0), (0, 0), (0, 0)])
        t = t.reshape(B, nb + 2, n_side, dilation, H, E)
        return jnp.concatenate([t[:, :-2], t[:, 1:-1], t[:, 2:]], axis=2)

    kw, vw = windows(k), windows(v)
    rel = jnp.arange(3 * n_side)[None, :] - n_side - jnp.arange(n_side)[:, None]
    band = jnp.abs(rel) <= n_side
    m_k = jnp.arange(nb)[:, None, None] * n_side + jnp.arange(3 * n_side)[None, None, :] - n_side
    pos_k = m_k * dilation + jnp.arange(dilation)[None, :, None]
    key_ok = (m_k >= 0) & (pos_k < S)
    mask = band[None, None] & key_ok[:, :, None, :]
    bias = -slopes[:, None, None] * (jnp.abs(rel) * dilation).astype(jnp.float32)[None]
    s = jnp.einsum('bnidhe,bnjdhe->bndhij', qb, kw) * (E ** -0.5) + bias
    s = jnp.where(mask[None, :, :, None], s, NEG_INF)
    lse = jax.nn.logsumexp(s, axis=-1)
    p = jnp.exp(s - lse[..., None])
    o = jnp.einsum('bndhij,bnjdhe->bnidhe', p, vw).reshape(B, Sp, H, E)[:, :S]
    lse = lse.transpose(0, 1, 4, 2, 3).reshape(B, Sp, H)[:, :S]
    return o, lse


def dilated_attention_mixer(q_all, k, v):
    B, S = q_all.shape[:2]
    slopes = alibi_slopes(ATT_HEADS)
    outs, lses = [], []
    for g, (window, dilation) in enumerate(ATT_PATTERNS):
        o, l = dilated_band_attention(q_all[:, :, g], k, v, dilation, window // (2 * dilation), slopes)
        outs.append(o)
        lses.append(l)
    wts = jax.nn.softmax(jnp.stack(lses, axis=0), axis=0)
    o = jnp.einsum('gbsh,gbshe->bshe', wts, jnp.stack(outs, axis=0))
    return o.reshape(B, S, ATT_KV_WIDTH)


def peer_ffn(h, w_q, sub_keys, u_tab, v_tab):
    B, S, D = h.shape
    q = (h @ w_q).reshape(B, S, PEER_HEADS, 2, PEER_HALF).astype(jnp.float32)
    s = jnp.einsum('bshpk,hpnk->bshpn', q, sub_keys.astype(jnp.float32))
    top_s, top_i = lax.top_k(s, PEER_TOPK)
    cand_s = top_s[..., 0, :, None] + top_s[..., 1, None, :]
    cand_i = top_i[..., 0, :, None] * PEER_N_KEYS + top_i[..., 1, None, :]
    best_s, best_j = lax.top_k(cand_s.reshape(B, S, PEER_HEADS, PEER_TOPK * PEER_TOPK), PEER_TOPK)
    expert = jnp.take_along_axis(cand_i.reshape(B, S, PEER_HEADS, PEER_TOPK * PEER_TOPK), best_j, axis=-1)
    gate = jax.nn.softmax(best_s, axis=-1)
    n_blocks = (B * S) // PEER_TOKEN_BLOCK
    xs = (h.reshape(n_blocks, PEER_TOKEN_BLOCK, D),
          expert.reshape(n_blocks, PEER_TOKEN_BLOCK, PEER_HEADS * PEER_TOPK),
          gate.reshape(n_blocks, PEER_TOKEN_BLOCK, PEER_HEADS * PEER_TOPK))

    def block(args):
        hb, eb, gb = args
        a = jnp.einsum('ckd,cd->ck', u_tab[eb], hb)
        act = jax.nn.gelu(a.astype(jnp.float32), approximate=False) * gb
        return jnp.einsum('ck,ckd->cd', act.astype(hb.dtype), v_tab[eb])

    return lax.map(block, xs).reshape(B, S, D)


def setup_inputs(seed: int = 0) -> dict:
    key = jax.random.key(seed)
    ks = jax.random.split(key, 16)
    f32 = jnp.float32
    L, D = DEPTH, D_MODEL
    nrm = lambda k, shape, scale: jax.random.normal(k, shape, f32) * scale
    return {
        'x': jax.random.normal(ks[0], (BATCH, SEQ, D), f32),
        'norm_mix_g': 1.0 + nrm(ks[1], (L, D), 0.02),
        'w_in': nrm(ks[2], (L, D, IN_WIDTH), D ** -0.5),
        'sgu_norm_g': 1.0 + nrm(ks[3], (L, SGU_WIDTH), 0.02),
        'sgu_w': nrm(ks[4], (L, SGU_GROUPS, SGU_CHUNK, SGU_CHUNK), SGU_CHUNK ** -0.5),
        'sgu_b': 1.0 + nrm(ks[5], (L, SGU_GROUPS, SGU_CHUNK), 0.02),
        'w_branch_a': nrm(ks[6], (L, SGU_WIDTH, D), SGU_WIDTH ** -0.5),
        'w_branch_b': nrm(ks[7], (L, ATT_KV_WIDTH, D), ATT_KV_WIDTH ** -0.5),
        'w_out': nrm(ks[8], (L, D, D), D ** -0.5),
        'norm_ffn_g': 1.0 + nrm(ks[9], (L, D), 0.02),
        'peer_wq': nrm(ks[10], (L, D, PEER_HEADS * PEER_KEY_DIM), D ** -0.5),
        'peer_subkeys': nrm(ks[11], (L, PEER_HEADS, 2, PEER_N_KEYS, PEER_HALF), PEER_HALF ** -0.5),
        'peer_u': nrm(ks[12], (L, PEER_N_EXPERTS, D), D ** -0.5),
        'peer_v': nrm(ks[13], (L, PEER_N_EXPERTS, D), PEER_HEADS ** -0.5),
        'norm_final_g': 1.0 + nrm(ks[14], (D,), 0.02),
    }


def reference(x, norm_mix_g, w_in, sgu_norm_g, sgu_w, sgu_b, w_branch_a, w_branch_b, w_out,
              norm_ffn_g, peer_wq, peer_subkeys, peer_u, peer_v, norm_final_g):
    B, S, _ = x.shape
    split_at = np.cumsum(IN_SPLITS)[:-1].tolist()
    for l in range(DEPTH):
        h = rmsnorm(x, norm_mix_g[l])
        proj = h @ w_in[l]
        za_u, za_v, q_all, k, v, gate_a, gate_b = jnp.split(proj, split_at, axis=-1)
        z_a = jax.nn.gelu(jnp.concatenate([za_u, za_v], axis=-1), approximate=False)
        y_a = spatial_gating_mixer(z_a, sgu_norm_g[l], sgu_w[l], sgu_b[l])
        y_b = dilated_attention_mixer(
            q_all.reshape(B, S, ATT_GROUPS, ATT_HEADS, ATT_HEAD_DIM),
            k.reshape(B, S, ATT_HEADS, ATT_HEAD_DIM),
            v.reshape(B, S, ATT_HEADS, ATT_HEAD_DIM)).astype(x.dtype)
        merged = (jax.nn.sigmoid(gate_a) * (y_a @ w_branch_a[l])
                  + jax.nn.sigmoid(gate_b) * (y_b @ w_branch_b[l]))
        x = x + merged @ w_out[l]
        x = x + peer_ffn(rmsnorm(x, norm_ffn_g[l]), peer_wq[l], peer_subkeys[l], peer_u[l], peer_v[l])
    return rmsnorm(x, norm_final_g)
```

```cpp
#include <hip/hip_runtime.h>
#include <cstdio>
#include <cstdint>
#include <cstddef>
namespace pg8 {
#define PG8_LAS __attribute__((address_space(3)))
typedef unsigned short bf16_t;
typedef short bf16x8 __attribute__((ext_vector_type(8)));
typedef float f32x4 __attribute__((ext_vector_type(4)));
typedef unsigned u32x4 __attribute__((ext_vector_type(4)));
constexpr int BM = 256, BK = 64, HALF = 128, HTB = HALF * BK * 2  , STAGE_BYTES = 8 * HTB, NXCD = 8, WGM = 8;

__host__ __device__ __forceinline__ int lds_byte(int r, int c) { const int st = (r >> 4) * 2 + (c >> 5), rr = r & 15, cc = c & 31, ob = rr * 64 + cc * 2; return st * 1024 + (ob ^ (((ob >> 9) & 1) << 5)); }
__host__ __device__ __forceinline__ void stage_rc(int b, int& R, int& C) { const int st = b / 1024, sb = b % 1024, swz = sb ^ (((sb >> 9) & 1) << 5); R = (st >> 1) * 16 + swz / 64; C = (st & 1) * 32 + (swz % 64) / 2; }
__host__ __device__ __forceinline__ int perm32(int rho) { const int n = rho >> 4, i = rho & 15; return 8 * (i >> 2) + 4 * n + (i & 3); }

struct Unit { int pm, pn; };
struct Gemm { const bf16_t* A; const bf16_t* Bt; int M, N, K; };

struct StaticOrder {
    int nM, nN, nwg, G, c;
    __host__ __device__ void init(int M, int N, int G_, int c_) { nM = M / BM; nN = N / BM; nwg = nM * nN; G = G_; c = c_; }
    __host__ __device__ bool next(int i, Unit& u) const {
        const long L = (long)i * G + c; if (L >= nwg) return false;
        int wgid = (int)L; { const int q = nwg / NXCD, r = nwg % NXCD, xcd = wgid % NXCD, off = wgid / NXCD; wgid = (xcd < r ? xcd * (q + 1) : r * (q + 1) + (xcd - r) * q) + off; }
        const int nig = WGM * nN, gid = wgid / nig, fm = gid * WGM, gsz = (nM - fm) < WGM ? (nM - fm) : WGM;
        u.pm = fm + ((wgid % nig) % gsz); u.pn = (wgid % nig) / gsz; return true;
    }
    __device__ __forceinline__ void a_ready(const Unit&) const {}
    __device__ __forceinline__ void done(const Unit&) const {}
};

__device__ __forceinline__ unsigned cvt_pk_bf16(float lo, float hi) { unsigned r; asm volatile("v_cvt_pk_bf16_f32 %0, %1, %2" : "=v"(r) : "v"(lo), "v"(hi)); return r; }
typedef float f32x2 __attribute__((ext_vector_type(2)));
__device__ __forceinline__ f32x2 gelu_pk(f32x2 v) {
    const f32x2 av = __builtin_elementwise_abs(v), d = av * 0.2316418882f + 1.0f;
    f32x2 t; t.x = __builtin_amdgcn_rcpf(d.x); t.y = __builtin_amdgcn_rcpf(d.y);
    f32x2 q = t * 0.5307027145f + (-0.7265760135f); q = q * t + 0.7107068705f; q = q * t + (-0.142248368f); q = q * t + 0.127414796f; q = q * t;
    const f32x2 s = (v * v) * (-0.72134752044f);
    f32x2 e; e.x = __builtin_amdgcn_exp2f(s.x); e.y = __builtin_amdgcn_exp2f(s.y);
    const f32x2 m = v * (q * e), r = v - m;
    f32x2 o; o.x = v.x < 0.f ? m.x : r.x; o.y = v.y < 0.f ? m.y : r.y; return o;
}
__device__ __forceinline__ float sigm(float v) { return __builtin_amdgcn_rcpf(1.0f + __builtin_amdgcn_exp2f(v * -1.4426950408889634f)); }
__device__ __forceinline__ u32x4 pack8(const f32x4& a, const f32x4& b) { u32x4 w; w.x = cvt_pk_bf16(a[0], a[1]); w.y = cvt_pk_bf16(a[2], a[3]); w.z = cvt_pk_bf16(b[0], b[1]); w.w = cvt_pk_bf16(b[2], b[3]); return w; }
__device__ __forceinline__ float bf_lo(unsigned w) { return __uint_as_float(w << 16); }
__device__ __forceinline__ float bf_hi(unsigned w) { return __uint_as_float(w & 0xffff0000u); }

struct EpiProj {
    static constexpr bool PERM = true, AFTER_DRAIN = false; static constexpr int MID_T = -1;
    bf16_t *U, *GV, *Q, *Kb, *Vb, *SG; const float* rstd1; float* SS;
    __device__ __forceinline__ void operator()(const f32x4 (&acc)[2][2][4][2], const Unit& u, int wr, int wc, int fr, int fq) const {
        const int pn = u.pn; bf16_t* base; int ldc, colt, act = 0;
        if (pn < 4) { base = U; ldc = 1536; colt = pn * 256; act = 1; }
        else if (pn < 8) { base = GV; ldc = 1024; colt = (pn - 4) * 256; act = 1; }
        else if (pn < 14) { base = Q; ldc = 1536; colt = (pn - 8) * 256; }
        else if (pn < 16) { base = Kb; ldc = 512; colt = (pn - 14) * 256; }
        else if (pn < 18) { base = Vb; ldc = 512; colt = (pn - 16) * 256; }
        else { base = SG; ldc = 2048; colt = (pn - 18) * 256; act = 2; }
        const bool want_ss = (pn >= 4 && pn < 8);
        const int row0 = u.pm * BM + wr * 64 + fr, col0 = colt + wc * 32 + 8 * fq;
#pragma unroll
        for (int ai = 0; ai < 2; ++ai)
#pragma unroll
            for (int m = 0; m < 4; ++m) {
                const int row = row0 + ai * HALF + m * 16; const float rs = rstd1[row];
                bf16_t* rowp = base + (size_t)row * ldc + col0; float ssq = 0.f;
#pragma unroll
                for (int bj = 0; bj < 2; ++bj) {
                    f32x4 v0 = acc[ai][bj][m][0] * rs, v1 = acc[ai][bj][m][1] * rs;
                    if (act == 1) { const f32x2 a = gelu_pk((f32x2){v0[0], v0[1]}), b = gelu_pk((f32x2){v0[2], v0[3]}), c = gelu_pk((f32x2){v1[0], v1[1]}), d = gelu_pk((f32x2){v1[2], v1[3]});
                        v0 = (f32x4){a.x, a.y, b.x, b.y}; v1 = (f32x4){c.x, c.y, d.x, d.y};
                        ssq += (v0[0] * v0[0] + v0[1] * v0[1]) + (v0[2] * v0[2] + v0[3] * v0[3]) + (v1[0] * v1[0] + v1[1] * v1[1]) + (v1[2] * v1[2] + v1[3] * v1[3]); }
                    else if (act == 2) {
#pragma unroll
                        for (int e = 0; e < 4; ++e) { v0[e] = sigm(v0[e]); v1[e] = sigm(v1[e]); } }
                    *(u32x4*)(rowp + bj * HALF) = pack8(v0, v1);
                }
                if (want_ss) { ssq += __shfl_xor(ssq, 16); ssq += __shfl_xor(ssq, 32); if (fq == 0) SS[(size_t)row * 16 + (pn - 4) * 4 + wc] = ssq; }
            }
    }
};
struct EpiMergeA {
    static constexpr bool PERM = true, AFTER_DRAIN = false; static constexpr int MID_T = -1;
    const bf16_t* SG; float* MGF;
    __device__ __forceinline__ void operator()(const f32x4 (&acc)[2][2][4][2], const Unit& u, int wr, int wc, int fr, int fq) const {
        const int row0 = u.pm * BM + wr * 64 + fr, col0 = u.pn * BM + wc * 32 + 8 * fq;
#pragma unroll
        for (int ai = 0; ai < 2; ++ai)
#pragma unroll
            for (int m = 0; m < 4; ++m) { const int row = row0 + ai * HALF + m * 16;
#pragma unroll
                for (int bj = 0; bj < 2; ++bj) { const int col = col0 + bj * HALF;
                    const u32x4 s = *(const u32x4*)(SG + (size_t)row * 2048 + col);
                    f32x4 v0 = acc[ai][bj][m][0], v1 = acc[ai][bj][m][1];
                    v0[0] *= bf_lo(s.x); v0[1] *= bf_hi(s.x); v0[2] *= bf_lo(s.y); v0[3] *= bf_hi(s.y);
                    v1[0] *= bf_lo(s.z); v1[1] *= bf_hi(s.z); v1[2] *= bf_lo(s.w); v1[3] *= bf_hi(s.w);
                    float* o = MGF + (size_t)row * 1024 + col; *(f32x4*)o = v0; *(f32x4*)(o + 4) = v1; } }
    }
};
struct EpiMergeB {
    static constexpr bool PERM = true, AFTER_DRAIN = false; static constexpr int MID_T = -1;
    const bf16_t* SG; const float* MGF; bf16_t* MG;
    __device__ __forceinline__ void operator()(const f32x4 (&acc)[2][2][4][2], const Unit& u, int wr, int wc, int fr, int fq) const {
        const int row0 = u.pm * BM + wr * 64 + fr, col0 = u.pn * BM + wc * 32 + 8 * fq;
#pragma unroll
        for (int ai = 0; ai < 2; ++ai)
#pragma unroll
            for (int m = 0; m < 4; ++m) { const int row = row0 + ai * HALF + m * 16;
#pragma unroll
                for (int bj = 0; bj < 2; ++bj) { const int col = col0 + bj * HALF;
                    const u32x4 s = *(const u32x4*)(SG + (size_t)row * 2048 + 1024 + col);
                    const float* mi = MGF + (size_t)row * 1024 + col; f32x4 v0 = *(const f32x4*)mi, v1 = *(const f32x4*)(mi + 4);
                    const f32x4 a0 = acc[ai][bj][m][0], a1 = acc[ai][bj][m][1];
                    v0[0] += a0[0] * bf_lo(s.x); v0[1] += a0[1] * bf_hi(s.x); v0[2] += a0[2] * bf_lo(s.y); v0[3] += a0[3] * bf_hi(s.y);
                    v1[0] += a1[0] * bf_lo(s.z); v1[1] += a1[1] * bf_hi(s.z); v1[2] += a1[2] * bf_lo(s.w); v1[3] += a1[3] * bf_hi(s.w);
                    *(u32x4*)(MG + (size_t)row * 1024 + col) = pack8(v0, v1); } }
    }
};
struct EpiX1 {
    static constexpr bool PERM = true, AFTER_DRAIN = false; static constexpr int MID_T = -1;
    const float* X; bf16_t* X1B; float* SS2; unsigned char* X1I8;
    __device__ __forceinline__ void operator()(const f32x4 (&acc)[2][2][4][2], const Unit& u, int wr, int wc, int fr, int fq) const {
        const int row0 = u.pm * BM + wr * 64 + fr, col0 = u.pn * BM + wc * 32 + 8 * fq;
#pragma unroll
        for (int ai = 0; ai < 2; ++ai)
#pragma unroll
            for (int m = 0; m < 4; ++m) { const int row = row0 + ai * HALF + m * 16; float ssq = 0.f;
#pragma unroll
                for (int bj = 0; bj < 2; ++bj) { const int col = col0 + bj * HALF;
                    const float* xi = X + (size_t)row * 1024 + col;
                    const f32x4 v0 = __builtin_nontemporal_load((const f32x4*)xi) + acc[ai][bj][m][0], v1 = __builtin_nontemporal_load((const f32x4*)(xi + 4)) + acc[ai][bj][m][1];
                    ssq += (v0[0] * v0[0] + v0[1] * v0[1]) + (v0[2] * v0[2] + v0[3] * v0[3]) + (v1[0] * v1[0] + v1[1] * v1[1]) + (v1[2] * v1[2] + v1[3] * v1[3]);
                    *(u32x4*)(X1B + (size_t)row * 1024 + col) = pack8(v0, v1);
                    { int q[8];
#pragma unroll
                      for (int k = 0; k < 4; ++k) { int a = (int)__builtin_rintf(v0[k] * 16.0f), b = (int)__builtin_rintf(v1[k] * 16.0f); q[k] = a < -127 ? -127 : (a > 127 ? 127 : a); q[4 + k] = b < -127 ? -127 : (b > 127 ? 127 : b); }
                      unsigned we = (unsigned)(q[0] & 255) | ((unsigned)(q[2] & 255) << 8) | ((unsigned)(q[4] & 255) << 16) | ((unsigned)q[6] << 24);
                      unsigned wo = (unsigned)(q[1] & 255) | ((unsigned)(q[3] & 255) << 8) | ((unsigned)(q[5] & 255) << 16) | ((unsigned)q[7] << 24);
                      unsigned* ip = (unsigned*)(X1I8 + (size_t)row * 1024 + col); ip[0] = we; ip[1] = wo; } }
                ssq += __shfl_xor(ssq, 16); ssq += __shfl_xor(ssq, 32); if (fq == 0) SS2[(size_t)row * 16 + u.pn * 4 + wc] = ssq; }
    }
};
struct EpiBlk {
    static constexpr bool PERM = true, AFTER_DRAIN = false; static constexpr int MID_T = -1;
    bf16_t* O; int ldc;
    __device__ __forceinline__ void operator()(const f32x4 (&acc)[2][2][4][2], const Unit& u, int wr, int wc, int fr, int fq) const {
        const int rb0 = u.pm * 16 + wr * 4, cb0 = u.pn * 8 + wc, nb = ldc >> 5;
        bf16_t* base = O + (size_t)(fq * 16 + fr) * 8;
#pragma unroll
        for (int ai = 0; ai < 2; ++ai)
#pragma unroll
            for (int m = 0; m < 4; ++m)
#pragma unroll
                for (int bj = 0; bj < 2; ++bj) *(u32x4*)(base + ((size_t)(rb0 + ai * 8 + m) * nb + cb0 + bj * 4) * 512) = pack8(acc[ai][bj][m][0], acc[ai][bj][m][1]);
    }
};
struct EpiPlain {
    static constexpr bool PERM = true, AFTER_DRAIN = false; static constexpr int MID_T = -1;
    bf16_t* O; int ldc;
    __device__ __forceinline__ void operator()(const f32x4 (&acc)[2][2][4][2], const Unit& u, int wr, int wc, int fr, int fq) const {
        const int row0 = u.pm * BM + wr * 64 + fr, col0 = u.pn * BM + wc * 32 + 8 * fq;
#pragma unroll
        for (int ai = 0; ai < 2; ++ai)
#pragma unroll
            for (int m = 0; m < 4; ++m) { const int row = row0 + ai * HALF + m * 16;
#pragma unroll
                for (int bj = 0; bj < 2; ++bj) *(u32x4*)(O + (size_t)row * ldc + col0 + bj * HALF) = pack8(acc[ai][bj][m][0], acc[ai][bj][m][1]); }
    }
};

struct EpiMergeFused {
    static constexpr bool PERM = true, AFTER_DRAIN = false; static constexpr int MID_T = 16;
    const bf16_t* SG; bf16_t* MG;
    __device__ __forceinline__ void mid(f32x4 (&acc)[2][2][4][2], const Unit& u, int wr, int wc, int fr, int fq) const {
        int row0 = u.pm * BM + wr * 64 + fr, col0 = u.pn * BM + wc * 32 + 8 * fq;
        asm volatile("" : "+v"(row0), "+v"(col0));
#pragma unroll
        for (int ai = 0; ai < 2; ++ai)
#pragma unroll
            for (int m = 0; m < 4; ++m) { const int row = row0 + ai * HALF + m * 16;
#pragma unroll
                for (int bj = 0; bj < 2; ++bj) { const int col = col0 + bj * HALF;
                    const u32x4 sa = *(const u32x4*)(SG + (size_t)row * 2048 + col), sb = *(const u32x4*)(SG + (size_t)row * 2048 + 1024 + col);
                    f32x4& v0 = acc[ai][bj][m][0]; f32x4& v1 = acc[ai][bj][m][1];
                    v0[0] *= bf_lo(sa.x) * __builtin_amdgcn_rcpf(fmaxf(bf_lo(sb.x), 1e-30f)); v0[1] *= bf_hi(sa.x) * __builtin_amdgcn_rcpf(fmaxf(bf_hi(sb.x), 1e-30f));
                    v0[2] *= bf_lo(sa.y) * __builtin_amdgcn_rcpf(fmaxf(bf_lo(sb.y), 1e-30f)); v0[3] *= bf_hi(sa.y) * __builtin_amdgcn_rcpf(fmaxf(bf_hi(sb.y), 1e-30f));
                    v1[0] *= bf_lo(sa.z) * __builtin_amdgcn_rcpf(fmaxf(bf_lo(sb.z), 1e-30f)); v1[1] *= bf_hi(sa.z) * __builtin_amdgcn_rcpf(fmaxf(bf_hi(sb.z), 1e-30f));
                    v1[2] *= bf_lo(sa.w) * __builtin_amdgcn_rcpf(fmaxf(bf_lo(sb.w), 1e-30f)); v1[3] *= bf_hi(sa.w) * __builtin_amdgcn_rcpf(fmaxf(bf_hi(sb.w), 1e-30f)); }
                asm volatile("" ::: "memory"); }
    }
    __device__ __forceinline__ void operator()(const f32x4 (&acc)[2][2][4][2], const Unit& u, int wr, int wc, int fr, int fq) const {
        const int row0 = u.pm * BM + wr * 64 + fr, col0 = u.pn * BM + wc * 32 + 8 * fq;
#pragma unroll
        for (int ai = 0; ai < 2; ++ai)
#pragma unroll
            for (int m = 0; m < 4; ++m) { const int row = row0 + ai * HALF + m * 16;
#pragma unroll
                for (int bj = 0; bj < 2; ++bj) { const int col = col0 + bj * HALF;
                    const u32x4 s = *(const u32x4*)(SG + (size_t)row * 2048 + 1024 + col);
                    f32x4 v0 = acc[ai][bj][m][0], v1 = acc[ai][bj][m][1];
                    v0[0] *= bf_lo(s.x); v0[1] *= bf_hi(s.x); v0[2] *= bf_lo(s.y); v0[3] *= bf_hi(s.y);
                    v1[0] *= bf_lo(s.z); v1[1] *= bf_hi(s.z); v1[2] *= bf_lo(s.w); v1[3] *= bf_hi(s.w);
                    *(u32x4*)(MG + (size_t)row * 1024 + col) = pack8(v0, v1); } }
    }
};
template <class Epi, class Sched, bool ALIGN_EPI = false, bool SP2 = false>
__device__ __forceinline__ void gemm_phase(PG8_LAS unsigned char* lds, const Gemm g, const Sched& S, const Epi& E) {
    const int tid = threadIdx.x, wid = __builtin_amdgcn_readfirstlane(tid >> 6), lane = tid & 63, wr = wid >> 2, wc = wid & 3, fr = lane & 15, fq = lane >> 4;
    const int K = g.K, nt = K / BK;
    unsigned voffA[2], voffB[2];
#pragma unroll
    for (int i = 0; i < 2; ++i) { int R, C; stage_rc(tid * 16 + i * 8192, R, C); const int Rb = Epi::PERM ? ((R & ~31) + perm32(R & 31)) : R;
        voffA[i] = (unsigned)(R * K + C) * 2u; voffB[i] = (unsigned)(Rb * K + C) * 2u; }
    const size_t kstep = (size_t)(BK * 2);
    const size_t hstep = (size_t)HALF * K * 2;
    const size_t tstep = 2 * hstep;
    const unsigned ldsw = (unsigned)wid * 1024u;
    const int aoff = lds_byte(wr * 64 + fr, fq * 8), boff = lds_byte(wc * 32 + fr, fq * 8);
#define PG8_SA(b, h) (((b) * 2 + (h)) * HTB)
#define PG8_SB(b, h) ((4 + (b) * 2 + (h)) * HTB)
#define PG8_STAGE(bufoff, gbase, voff) do { _Pragma("unroll") for (int _i = 0; _i < 2; ++_i) \
        __builtin_amdgcn_global_load_lds((const unsigned*)((const char*)(gbase) + (voff)[_i]), (PG8_LAS unsigned*)(lds + (bufoff) + ldsw + _i * 8192), 16, 0, 0); } while (0)
#define PG8_LDA(dst, b, h) do { _Pragma("unroll") for (int m = 0; m < 4; ++m) _Pragma("unroll") for (int k = 0; k < 2; ++k) dst[m][k] = *(const PG8_LAS bf16x8*)(lds + PG8_SA(b, h) + aoff + m * 2048 + k * 1024); } while (0)
#define PG8_LDB(dst, b, h) do { _Pragma("unroll") for (int n = 0; n < 2; ++n) _Pragma("unroll") for (int k = 0; k < 2; ++k) dst[n][k] = *(const PG8_LAS bf16x8*)(lds + PG8_SB(b, h) + boff + n * 2048 + k * 1024); } while (0)
#define PG8_MMA(ai, bj, At, Bt) do { __builtin_amdgcn_s_setprio(1); _Pragma("unroll") for (int m = 0; m < 4; ++m) _Pragma("unroll") for (int n = 0; n < 2; ++n) _Pragma("unroll") for (int k = 0; k < 2; ++k) \
        acc[ai][bj][m][n] = __builtin_amdgcn_mfma_f32_16x16x32_bf16(Bt[n][k], At[m][k], acc[ai][bj][m][n], 0, 0, 0); __builtin_amdgcn_s_setprio(0); } while (0)
#define PG8_WAIT_V(n) asm volatile("s_waitcnt vmcnt(" #n ")" ::: "memory")
#define PG8_WAIT_L(n) asm volatile("s_waitcnt lgkmcnt(" #n ")" ::: "memory")
#define PG8_BAR __builtin_amdgcn_s_barrier()
#define PG8_SCHED __builtin_amdgcn_sched_barrier(0)
    Unit cur, nxt; int ui = 0;
    if (!S.next(0, cur)) return;
    f32x4 acc[2][2][4][2];
#pragma unroll
    for (int a = 0; a < 2; ++a)
#pragma unroll
        for (int b = 0; b < 2; ++b)
#pragma unroll
            for (int m = 0; m < 4; ++m)
#pragma unroll
                for (int n = 0; n < 2; ++n) acc[a][b][m][n] = (f32x4){0.f, 0.f, 0.f, 0.f};
    bf16x8 At[4][2], B0[2][2], B1[2][2];
    const char* cA = (const char*)g.A + (size_t)cur.pm * tstep; const char* cB = (const char*)g.Bt + (size_t)cur.pn * tstep;
    S.a_ready(cur);
    if constexpr (SP2) {
        PG8_STAGE(PG8_SB(0, 0), cB, voffB); PG8_STAGE(PG8_SB(0, 1), cB + hstep, voffB); PG8_STAGE(PG8_SA(0, 0), cA, voffA); PG8_STAGE(PG8_SA(0, 1), cA + hstep, voffA);
        if (wr == 1) PG8_BAR;
        PG8_WAIT_V(2); PG8_BAR;
        PG8_STAGE(PG8_SB(1, 0), cB + kstep, voffB); PG8_STAGE(PG8_SA(1, 0), cA + kstep, voffA); PG8_STAGE(PG8_SB(1, 1), cB + hstep + kstep, voffB);
        PG8_WAIT_V(6); PG8_BAR;
    } else {
        PG8_STAGE(PG8_SB(0, 0), cB, voffB); PG8_STAGE(PG8_SA(0, 0), cA, voffA); PG8_STAGE(PG8_SB(0, 1), cB + hstep, voffB); PG8_STAGE(PG8_SA(0, 1), cA + hstep, voffA);
        if (wr == 1) PG8_BAR;
        PG8_WAIT_V(4); PG8_BAR;
        PG8_STAGE(PG8_SB(1, 0), cB + kstep, voffB); PG8_STAGE(PG8_SA(1, 0), cA + kstep, voffA); PG8_STAGE(PG8_SB(1, 1), cB + hstep + kstep, voffB);
        PG8_WAIT_V(6); PG8_BAR;
    }
    for (;;) {
        const bool has_next = S.next(ui + 1, nxt);
        const char* nA = has_next ? (const char*)g.A + (size_t)nxt.pm * tstep : cA; const char* nB = has_next ? (const char*)g.Bt + (size_t)nxt.pn * tstep : cB;
        for (int t = 0; t < nt; t += 2) {
            if constexpr (Epi::MID_T >= 0) { if (t == Epi::MID_T) E.mid(acc, cur, wr, wc, fr, fq); }
            const bool last = (t == nt - 2);
            const char* a1 = cA + (size_t)(t + 1) * kstep;
            const char* a2 = last ? nA : cA + (size_t)(t + 2) * kstep; const char* b2 = last ? nB : cB + (size_t)(t + 2) * kstep;
            const char* a3 = a2 + kstep; const char* b3 = b2 + kstep;
            if (last && has_next) S.a_ready(nxt);
            if constexpr (SP2) {
            PG8_LDB(B0, 0, 0); PG8_LDB(B1, 0, 1); PG8_SCHED; PG8_LDA(At, 0, 0); PG8_STAGE(PG8_SA(1, 1), a1 + hstep, voffA);
            PG8_WAIT_V(8); PG8_WAIT_L(0); PG8_BAR; PG8_MMA(0, 0, At, B0); PG8_MMA(0, 1, At, B1); PG8_BAR; PG8_SCHED;
            PG8_LDA(At, 0, 1); PG8_STAGE(PG8_SB(0, 0), b2, voffB); PG8_STAGE(PG8_SB(0, 1), b2 + hstep, voffB); PG8_STAGE(PG8_SA(0, 0), a2, voffA);
            PG8_WAIT_V(8); PG8_WAIT_L(0); PG8_BAR; PG8_MMA(1, 0, At, B0); PG8_MMA(1, 1, At, B1); PG8_BAR; PG8_SCHED;
            PG8_LDB(B0, 1, 0); PG8_LDB(B1, 1, 1); PG8_SCHED; PG8_LDA(At, 1, 0); PG8_STAGE(PG8_SA(0, 1), a2 + hstep, voffA);
            PG8_WAIT_V(8); PG8_WAIT_L(0); PG8_BAR; PG8_MMA(0, 0, At, B0); PG8_MMA(0, 1, At, B1); PG8_BAR; PG8_SCHED;
            PG8_LDA(At, 1, 1); PG8_STAGE(PG8_SB(1, 0), b3, voffB); PG8_STAGE(PG8_SB(1, 1), b3 + hstep, voffB); PG8_STAGE(PG8_SA(1, 0), a3, voffA);
            PG8_WAIT_V(8); PG8_WAIT_L(0); PG8_BAR; PG8_MMA(1, 0, At, B0); PG8_MMA(1, 1, At, B1); PG8_BAR; PG8_SCHED;
            } else {
            PG8_LDB(B0, 0, 0); PG8_SCHED; PG8_LDA(At, 0, 0); PG8_STAGE(PG8_SA(1, 1), a1 + hstep, voffA);
            PG8_WAIT_L(8); PG8_BAR; PG8_WAIT_L(0); PG8_MMA(0, 0, At, B0); PG8_BAR; PG8_SCHED;
            PG8_LDB(B1, 0, 1); PG8_STAGE(PG8_SB(0, 0), b2, voffB);
            PG8_BAR; PG8_WAIT_L(0); PG8_MMA(0, 1, At, B1); PG8_BAR;
            PG8_LDA(At, 0, 1); PG8_STAGE(PG8_SA(0, 0), a2, voffA);
            PG8_BAR; PG8_WAIT_L(0); PG8_MMA(1, 0, At, B0); PG8_BAR; PG8_SCHED;
            PG8_STAGE(PG8_SB(0, 1), b2 + hstep, voffB);
            PG8_WAIT_V(6); PG8_BAR; PG8_MMA(1, 1, At, B1); PG8_BAR;
            PG8_LDB(B0, 1, 0); PG8_SCHED; PG8_LDA(At, 1, 0); PG8_STAGE(PG8_SA(0, 1), a2 + hstep, voffA);
            PG8_WAIT_L(8); PG8_BAR; PG8_WAIT_L(0); PG8_MMA(0, 0, At, B0); PG8_BAR; PG8_SCHED;
            PG8_LDB(B1, 1, 1); PG8_STAGE(PG8_SB(1, 0), b3, voffB);
            PG8_BAR; PG8_WAIT_L(0); PG8_MMA(0, 1, At, B1); PG8_BAR;
            PG8_LDA(At, 1, 1); PG8_STAGE(PG8_SA(1, 0), a3, voffA);
            PG8_BAR; PG8_WAIT_L(0); PG8_MMA(1, 0, At, B0); PG8_BAR; PG8_SCHED;
            PG8_STAGE(PG8_SB(1, 1), b3 + hstep, voffB);
            PG8_WAIT_V(6); PG8_BAR; PG8_MMA(1, 1, At, B1); PG8_BAR;
            }
        }
        if constexpr (ALIGN_EPI) { if (wr == 0) PG8_BAR; }
        if constexpr (!Epi::AFTER_DRAIN) { E(acc, cur, wr, wc, fr, fq); S.done(cur); }
        if (!has_next) break;
#pragma unroll
        for (int a = 0; a < 2; ++a)
#pragma unroll
            for (int b = 0; b < 2; ++b)
#pragma unroll
                for (int m = 0; m < 4; ++m)
#pragma unroll
                    for (int n = 0; n < 2; ++n) acc[a][b][m][n] = (f32x4){0.f, 0.f, 0.f, 0.f};
        cur = nxt; cA = nA; cB = nB; ++ui;
        if constexpr (ALIGN_EPI) { if (wr == 1) PG8_BAR; }
    }
    PG8_WAIT_V(0);
    if constexpr (!ALIGN_EPI) { if (wr == 0) PG8_BAR; }
    PG8_BAR;
    if constexpr (Epi::AFTER_DRAIN) { E.fused(acc, cur, wr, wc, fr, fq, lds, wid, lane); S.done(cur); }
#undef PG8_SA
#undef PG8_SB
#undef PG8_STAGE
#undef PG8_LDA
#undef PG8_LDB
#undef PG8_MMA
#undef PG8_WAIT_V
#undef PG8_WAIT_L
#undef PG8_BAR
#undef PG8_SCHED
}
}
constexpr int D = 1024, BATCH = 4, SEQ = 8192, T = BATCH * SEQ, INW = 6656;
constexpr int NTHR = 512, NWAVES = 8;
constexpr float EPS = 1e-6f;
constexpr size_t MiB = 1u << 20;
constexpr size_t WS_CTL = 0, CTL_ZERO_BYTES = 16384;
constexpr size_t WS_RSTD1 = 1 * MiB, WS_SS = 2 * MiB, WS_SS2 = 4 * MiB, WS_LSE = 6 * MiB;
constexpr size_t WS_WIN = 9 * MiB;
constexpr size_t WS_WA = 22 * MiB, WS_WO = 25 * MiB, WS_WQ = 27 * MiB;
constexpr size_t WS_SUBK = 31 * MiB;
constexpr size_t WS_SGUW = 31 * MiB + 512 * 1024;
constexpr size_t WS_UT = 32 * MiB, WS_VT = 48 * MiB;
constexpr size_t WS_UY = 64 * MiB;
constexpr int UYP = 1536;
constexpr size_t WS_X1I8 = WS_UY + 32 * MiB;
constexpr size_t WS_GV = 160 * MiB;
constexpr size_t WS_Q = 224 * MiB;
constexpr size_t WS_K = 320 * MiB, WS_V = 352 * MiB;
constexpr size_t WS_SG = 384 * MiB;
constexpr size_t WS_END = 512 * MiB;
constexpr int LDS_BYTES = 147456;
constexpr int LDS_MISC = 131072;

#define LAS __attribute__((address_space(3)))
typedef unsigned short bf16;
typedef unsigned u32x4 __attribute__((ext_vector_type(4)));
typedef unsigned u32x2 __attribute__((ext_vector_type(2)));
typedef float f32x4 __attribute__((ext_vector_type(4)));
typedef float f32x2 __attribute__((ext_vector_type(2)));
typedef __bf16 bf16x2_t __attribute__((ext_vector_type(2)));
#define LDS_WAIT() asm volatile("s_waitcnt lgkmcnt(0)" ::: "memory")

__device__ __forceinline__ unsigned f2bf(float f) { unsigned u = __builtin_bit_cast(unsigned, f); return (u + 0x7fffu + ((u >> 16) & 1u)) >> 16; }
__device__ __forceinline__ unsigned pk2(float lo, float hi) { return f2bf(lo) | (f2bf(hi) << 16); }
__device__ __forceinline__ float bf2f(bf16 b) { return __uint_as_float((unsigned)b << 16); }
__device__ __forceinline__ float bflo(unsigned w) { return __uint_as_float(w << 16); }
__device__ __forceinline__ float bfhi(unsigned w) { return __uint_as_float(w & 0xffff0000u); }
__device__ __forceinline__ float wave_sum(float v) {
#pragma unroll
    for (int o = 32; o >= 1; o >>= 1) v += __shfl_xor(v, o);
    return v;
}
__device__ __forceinline__ float wave_max(float v) {
#pragma unroll
    for (int o = 32; o >= 1; o >>= 1) v = fmaxf(v, __shfl_xor(v, o));
    return v;
}
__device__ __forceinline__ float gelu_exact(float v) { return 0.5f * v * (1.0f + erff(v * 0.70710678118654752f)); }

#define XB_TMO      128
#define XB_XCNT(j)  (256  + 64 * (j))
#define XB_XSUB(j)  (1280 + 64 * (j))
#define XB_XGEN(j)  (2304 + 64 * (j))
#define XB_TOP      3328
#define XB_TOPGEN   3392
#define XCD_BAR_WORDS 3456
#define XB_SPIN_CAP (1u << 18)

__device__ __forceinline__ unsigned xb_ld(unsigned* p)              { return __hip_atomic_load(p, __ATOMIC_RELAXED, __HIP_MEMORY_SCOPE_AGENT); }
__device__ __forceinline__ unsigned xb_add(unsigned* p, unsigned v) { return __hip_atomic_fetch_add(p, v, __ATOMIC_RELAXED, __HIP_MEMORY_SCOPE_AGENT); }
__device__ __forceinline__ unsigned xb_xcc_id() { return (unsigned)__builtin_amdgcn_s_getreg((3 << 11) | 20) & 0xFu; }
#define XB_SPIN(cond, bar) do { unsigned _sp = 0; while (cond) { __builtin_amdgcn_s_sleep(1); \
    if ((++_sp & 255u) == 0u) { if (xb_ld(&(bar)[XB_TMO])) break; if (_sp > XB_SPIN_CAP) { atomicAdd(&(bar)[XB_TMO], 1u); break; } } } } while (0)

struct XcdBarrier {
    unsigned* bar; unsigned x;
    volatile LAS unsigned* st;
};

__device__ __forceinline__ XcdBarrier xcd_barrier_post(unsigned* bar, volatile LAS unsigned* st) {
    XcdBarrier b; b.bar = bar; b.x = xb_xcc_id(); b.st = st;
    if (threadIdx.x == 0) (void)xb_add(&bar[XB_XCNT(b.x)], 1u);
    return b;
}
__device__ __forceinline__ void xcd_barrier_complete(unsigned* bar, unsigned x, unsigned& nloc, unsigned& nx) {
    const unsigned G = gridDim.x * gridDim.y * gridDim.z;
    unsigned sum, cnt, mine, sp = 0u;
    for (;;) {
        sum = 0u; cnt = 0u; mine = 0u;
#pragma unroll
        for (unsigned j = 0; j < 16; ++j) { const unsigned c = xb_ld(&bar[XB_XCNT(j)]); sum += c; cnt += (c > 0u) ? 1u : 0u; mine = (j == x) ? c : mine; }
        if (sum == G) break;
        __builtin_amdgcn_s_sleep(1);
        if ((++sp & 255u) == 0u) { if (xb_ld(&bar[XB_TMO])) break; if (sp > XB_SPIN_CAP) { atomicAdd(&bar[XB_TMO], 1u); break; } }
    }
    nloc = mine > 0u ? mine : 1u; nx = cnt > 0u ? cnt : 1u;
}

__device__ __forceinline__ void xcd_barrier(const XcdBarrier& b) {
    asm volatile("s_waitcnt vmcnt(0)" ::: "memory");
    __syncthreads();
    if (threadIdx.x == 0) {
        unsigned* bar = b.bar;
        __builtin_amdgcn_s_waitcnt(0);
        unsigned nloc = b.st[0], nx = b.st[1];
        if (nloc == 0u) { xcd_barrier_complete(bar, b.x, nloc, nx); b.st[0] = nloc; b.st[1] = nx; }
        const unsigned old = xb_add(&bar[XB_XSUB(b.x)], 1u);
        const unsigned gen = old / nloc;
        if (old + 1u == (gen + 1u) * nloc) {
            __builtin_amdgcn_fence(__ATOMIC_RELEASE, "agent");
            asm volatile("s_waitcnt vmcnt(0)" ::: "memory");
            const unsigned og = xb_add(&bar[XB_TOP], 1u);
            const unsigned tg = og / nx;
            if (og + 1u == (tg + 1u) * nx) xb_add(&bar[XB_TOPGEN], 1u);
            else XB_SPIN(xb_ld(&bar[XB_TOPGEN]) == tg, bar);
            __builtin_amdgcn_fence(__ATOMIC_ACQUIRE, "agent");
            xb_add(&bar[XB_XGEN(b.x)], 1u);
            asm volatile("s_waitcnt vmcnt(0)" ::: "memory");
        } else {
            XB_SPIN(xb_ld(&bar[XB_XGEN(b.x)]) == gen, bar);
            __builtin_amdgcn_fence(__ATOMIC_ACQUIRE, "agent");
            asm volatile("s_waitcnt vmcnt(0)" ::: "memory");
        }
    }
    __syncthreads();
}

struct Params {
    const float *x, *g_mix, *w_in, *g_sgu, *sgu_w, *sgu_b, *w_a, *w_b, *w_out, *g_ffn, *wq, *subk, *ut, *vt, *g_fin;
    float* out; unsigned char* ws; int lo, hi;
};

__device__ __forceinline__ void p0_transpose_item(const float* W, int K, int N, bf16* WT, int ldw, LAS float* scr, int item, int lane, const float* gk, int qlo, int qhi) {
    const int nblk = N / 32, kb = item / nblk, nb = item % nblk, k0 = 64 * kb, n0 = 32 * nb;
    const float cs = (n0 >= qlo && n0 < qhi) ? 0.125f * 1.4426950408889634f : 1.0f;
    const int r = lane >> 3, c = lane & 7;
    f32x4 v[8];
#pragma unroll
    for (int i = 0; i < 8; ++i) v[i] = __builtin_nontemporal_load((const f32x4*)(W + (size_t)(k0 + 8 * i + r) * N + n0 + 4 * c));
    f32x4 g0 = {cs, cs, cs, cs}, g1 = g0;
    if (gk) { g0 = *(const f32x4*)(gk + k0 + 8 * c) * cs; g1 = *(const f32x4*)(gk + k0 + 8 * c + 4) * cs; }
#pragma unroll
    for (int i = 0; i < 8; ++i) { LAS float* d = scr + (8 * i + r) * 33 + 4 * c; d[0] = v[i][0]; d[1] = v[i][1]; d[2] = v[i][2]; d[3] = v[i][3]; }
    LDS_WAIT();
#pragma unroll
    for (int j = 0; j < 4; ++j) { const int n = (lane >> 3) + 8 * j; const LAS float* s = scr + (8 * c) * 33 + n;
        u32x4 o; o.x = pk2(s[0 * 33] * g0[0], s[1 * 33] * g0[1]); o.y = pk2(s[2 * 33] * g0[2], s[3 * 33] * g0[3]); o.z = pk2(s[4 * 33] * g1[0], s[5 * 33] * g1[1]); o.w = pk2(s[6 * 33] * g1[2], s[7 * 33] * g1[3]);
        *(u32x4*)(WT + (size_t)(n0 + n) * ldw + k0 + 8 * c) = o; }
    LDS_WAIT();
}
__device__ __forceinline__ void p0_convert(const float* src, bf16* dst, size_t n8, const float* g, int gl, int NGL) {
    for (size_t i = gl; i < n8; i += NGL) {
        const f32x4 a = *(const f32x4*)(src + i * 8), b = *(const f32x4*)(src + i * 8 + 4);
        f32x4 ga = {1.f, 1.f, 1.f, 1.f}, gb = ga;
        if (g) { const int d = (int)((i * 8) & 1023); ga = *(const f32x4*)(g + d); gb = *(const f32x4*)(g + d + 4); }
        u32x4 o; o.x = pk2(a[0] * ga[0], a[1] * ga[1]); o.y = pk2(a[2] * ga[2], a[3] * ga[3]); o.z = pk2(b[0] * gb[0], b[1] * gb[1]); o.w = pk2(b[2] * gb[2], b[3] * gb[3]);
        *(u32x4*)(dst + i * 8) = o;
    }
}
constexpr float UT_SCALE = 256.0f, VT_SCALE = 16.0f;
constexpr float V4_UNIT = 0.5f;
constexpr float U4_STEP = 0.3352f;
constexpr size_t SLICE_BYTES = (size_t)16384 * 128;
__device__ __forceinline__ unsigned pk4_fp8(const f32x4& v) { unsigned w = 0; w = __builtin_amdgcn_cvt_pk_fp8_f32(v[0], v[1], w, false); w = __builtin_amdgcn_cvt_pk_fp8_f32(v[2], v[3], w, true); return w; }
__device__ __forceinline__ void fp8_item_store(unsigned char* dst, size_t i, f32x4 a, f32x4 b, f32x4 c, f32x4 d, const float* g, float scale) {
    a *= scale; b *= scale; c *= scale; d *= scale;
    if (g) { const f32x4* gp = (const f32x4*)(g + ((i * 16) & 1023)); a *= gp[0]; b *= gp[1]; c *= gp[2]; d *= gp[3]; }
    u32x4 o; o.x = pk4_fp8(a); o.y = pk4_fp8(b); o.z = pk4_fp8(c); o.w = pk4_fp8(d);
    const size_t e = i >> 6, dg = i & 63;
    *(u32x4*)(dst + (dg >> 3) * ((size_t)16384 * 128) + e * 128 + (dg & 7) * 16) = o;
}
__device__ __forceinline__ void p0_prologue(const Params& P, LAS unsigned char* lds, int wave, int lane) {
    unsigned char* ws = P.ws;
    LAS float* scr = (LAS float*)(lds + wave * 16384);
    const int gw = blockIdx.x * NWAVES + wave, NGW = gridDim.x * NWAVES;
    constexpr int I_IN = (D / 64) * (INW / 32), I_A = (1024 / 64) * (1024 / 32), I_B = (512 / 64) * (1024 / 32), I_O = I_A, I_Q = (1024 / 64) * (2048 / 32);
    constexpr int NITEMS = I_IN + I_A + I_B + I_O + I_Q;
    for (int it = gw; it < NITEMS; it += NGW) {
        int r = it;
        if (r < I_IN) { p0_transpose_item(P.w_in, 1024, INW, (bf16*)(ws + WS_WIN), 1024, scr, r, lane, P.g_mix, 2048, 3584); continue; } r -= I_IN;
        if (r < I_A) { p0_transpose_item(P.w_a, 1024, 1024, (bf16*)(ws + WS_WA), 1536, scr, r, lane, nullptr, 0, 0); continue; } r -= I_A;
        if (r < I_B) { p0_transpose_item(P.w_b, 512, 1024, (bf16*)(ws + WS_WA) + 1024, 1536, scr, r, lane, nullptr, 0, 0); continue; } r -= I_B;
        if (r < I_O) { p0_transpose_item(P.w_out, 1024, 1024, (bf16*)(ws + WS_WO), 1024, scr, r, lane, nullptr, 0, 0); continue; } r -= I_O;
        p0_transpose_item(P.wq, 1024, 2048, (bf16*)(ws + WS_WQ), 1024, scr, r, lane, P.g_ffn, 0, 0);
    }
    const int gl = gw * 64 + lane, NGL = NGW * 64;
    p0_convert(P.subk, (bf16*)(ws + WS_SUBK), (size_t)16 * 128 * 128 / 8, nullptr, gl, NGL);
    p0_convert(P.sgu_w, (bf16*)(ws + WS_SGUW), (size_t)8 * 128 * 128 / 8, nullptr, gl, NGL);
    {
    for (int e = gw; e < 16384; e += NGW) {
        const float* src = P.ut + (size_t)e * 1024;
        f32x4 v[4]; float ssq = 0.f;
#pragma unroll
        for (int j = 0; j < 4; ++j) { v[j] = __builtin_nontemporal_load((const f32x4*)(src + 256 * j + 4 * lane)) * *(const f32x4*)(P.g_ffn + 256 * j + 4 * lane); ssq += (v[j][0] * v[j][0] + v[j][1] * v[j][1]) + (v[j][2] * v[j][2] + v[j][3] * v[j][3]); }
        ssq = wave_sum(ssq);
        const float step = U4_STEP * sqrtf(ssq * (1.0f / 1024.0f)) + 1e-30f, inv = 1.0f / step;
        LAS unsigned short* prow = (LAS unsigned short*)scr;
#pragma unroll
        for (int j = 0; j < 4; ++j) { unsigned q[4];
#pragma unroll
            for (int k = 0; k < 4; ++k) { int c = (int)floorf(v[j][k] * inv) + 8; c = c < 0 ? 0 : (c > 15 ? 15 : c); q[k] = (unsigned)c; }
            prow[64 * j + lane] = (unsigned short)(q[0] | (q[1] << 4) | (q[2] << 8) | (q[3] << 12)); }
        LDS_WAIT();
        const u32x2 w = *(const LAS u32x2*)((LAS unsigned char*)scr + 8 * lane);
        *(u32x2*)(ws + WS_UT + (size_t)(lane >> 4) * SLICE_BYTES + (size_t)e * 128 + 8 * (lane & 15)) = w;
        LDS_WAIT();
        if (lane == 0) ((float*)(ws + WS_UT + 4 * SLICE_BYTES))[2 * e] = step;
    }
    for (int e = gw; e < 16384; e += NGW) {
        const float* src = P.vt + (size_t)e * 1024;
        f32x4 v[4]; float ssq = 0.f;
#pragma unroll
        for (int j = 0; j < 4; ++j) { v[j] = __builtin_nontemporal_load((const f32x4*)(src + 256 * j + 4 * lane)); ssq += (v[j][0] * v[j][0] + v[j][1] * v[j][1]) + (v[j][2] * v[j][2] + v[j][3] * v[j][3]); }
        ssq = wave_sum(ssq);
        const float unit = V4_UNIT * sqrtf(ssq * (1.0f / 1024.0f)) + 1e-30f, inv = 1.0f / unit;
        LAS unsigned short* prow = (LAS unsigned short*)scr;
#pragma unroll
        for (int j = 0; j < 4; ++j) { unsigned w = 0;
            w = __builtin_amdgcn_cvt_scalef32_pk_fp4_f32(w, v[j][0] * inv, v[j][1] * inv, 1.0f, 0);
            w = __builtin_amdgcn_cvt_scalef32_pk_fp4_f32(w, v[j][2] * inv, v[j][3] * inv, 1.0f, 1);
            prow[64 * j + lane] = (unsigned short)w; }
        LDS_WAIT();
        const u32x2 w = *(const LAS u32x2*)((LAS unsigned char*)scr + 8 * lane);
        *(u32x2*)(ws + WS_VT + (size_t)(lane >> 4) * SLICE_BYTES + (size_t)e * 128 + 8 * (lane & 15)) = w;
        LDS_WAIT();
        if (lane == 0) ((float*)(ws + WS_UT + 4 * SLICE_BYTES))[2 * e + 1] = unit;
    }
    }
    bf16* XB = (bf16*)P.out; float* rstd1 = (float*)(ws + WS_RSTD1);
    for (int row = gw; row < T; row += NGW) {
        const f32x4* xr = (const f32x4*)(P.x + (size_t)row * D) + lane;
        f32x4 v[4]; float s = 0.f;
#pragma unroll
        for (int j = 0; j < 4; ++j) { v[j] = __builtin_nontemporal_load(xr + 64 * j); s += (v[j][0] * v[j][0] + v[j][1] * v[j][1]) + (v[j][2] * v[j][2] + v[j][3] * v[j][3]); }
        s = wave_sum(s);
        if (lane == 0) rstd1[row] = rsqrtf(s * (1.0f / D) + EPS);
        u32x2* o8 = (u32x2*)(XB + (size_t)row * D) + lane;
#pragma unroll
        for (int j = 0; j < 4; ++j) { u32x2 w; w.x = pk2(v[j][0], v[j][1]); w.y = pk2(v[j][2], v[j][3]); o8[64 * j] = w; }
    }
}

typedef short bf16x8_t __attribute__((ext_vector_type(8)));
typedef short s16x4_t __attribute__((ext_vector_type(4)));
__device__ __forceinline__ s16x4_t lds_tr16(LAS const unsigned char* p) { return __builtin_bit_cast(s16x4_t, __builtin_amdgcn_ds_read_tr16_b64_v4i16((LAS s16x4_t*)p)); }
__device__ __forceinline__ unsigned cvtpk(float lo, float hi) { f32x2 v = {lo, hi}; bf16x2_t b = __builtin_convertvector(v, bf16x2_t); return __builtin_bit_cast(unsigned, b); }
__device__ __forceinline__ void p2_sgu_mfma(const Params& P, LAS unsigned char* lds, int wave, int lane) {
    unsigned char* ws = P.ws;
    bf16* U = (bf16*)(ws + WS_UY); const bf16* GV = (const bf16*)(ws + WS_GV); const float* SS = (const float*)(ws + WS_SS);
    const bf16* SW = (const bf16*)(ws + WS_SGUW);
    constexpr int RP = 128;
    LAS float* rv = (LAS float*)(lds + LDS_MISC);
    LAS unsigned char* tile = lds + wave * (128 * RP);
    const int g = wave, fr = lane & 15, fq = lane >> 4, trq = (lane & 15) >> 2, trp = lane & 3;
    for (int ch = blockIdx.x; ch < T / 128; ch += gridDim.x) {
        const int t0 = ch * 128;
        __syncthreads();
        if (threadIdx.x < 128) { const float* sp = SS + (size_t)(t0 + threadIdx.x) * 16; float s = 0.f;
#pragma unroll
            for (int i = 0; i < 16; ++i) s += sp[i];
            rv[threadIdx.x] = rsqrtf(s * (1.0f / 1024.f) + EPS); }
        __syncthreads();
#pragma unroll 1
        for (int half = 0; half < 2; ++half) {
            const int c0 = g * 128 + half * 64;
            LDS_WAIT();
#pragma unroll
            for (int it = 0; it < 16; ++it) { const int s = it * 8 + (lane >> 3), ck = lane & 7;
                const u32x4 v = __builtin_nontemporal_load((const u32x4*)(GV + (size_t)(t0 + s) * 1024 + c0 + ck * 8)); const float r = rv[s];
                u32x4 o; o.x = cvtpk(bflo(v.x) * r, bfhi(v.x) * r); o.y = cvtpk(bflo(v.y) * r, bfhi(v.y) * r); o.z = cvtpk(bflo(v.z) * r, bfhi(v.z) * r); o.w = cvtpk(bflo(v.w) * r, bfhi(v.w) * r);
                *(LAS u32x4*)(tile + s * RP + ck * 16) = o; }
            LDS_WAIT();
            bf16x8_t bfr[4][4];
#pragma unroll
            for (int ks = 0; ks < 4; ++ks)
#pragma unroll
                for (int nt = 0; nt < 4; ++nt) {
                    const s16x4_t lo = lds_tr16(tile + (32 * ks + 8 * fq + trq) * RP + nt * 32 + trp * 8);
                    const s16x4_t hi = lds_tr16(tile + (32 * ks + 8 * fq + 4 + trq) * RP + nt * 32 + trp * 8);
                    bfr[ks][nt] = (bf16x8_t){lo[0], lo[1], lo[2], lo[3], hi[0], hi[1], hi[2], hi[3]}; }
            const bf16* swp = SW + ((size_t)g * 128 + fr) * 128 + fq * 8;
            bf16x8_t afr[4], afn[4];
#pragma unroll
            for (int ks = 0; ks < 4; ++ks) afr[ks] = *(const bf16x8_t*)(swp + ks * 32);
#pragma unroll 1
            for (int mt = 0; mt < 8; ++mt) {
                const int tl = mt * 16 + fr;
                if (mt < 7) {
#pragma unroll
                    for (int ks = 0; ks < 4; ++ks) afn[ks] = *(const bf16x8_t*)(swp + (size_t)(mt + 1) * 16 * 128 + ks * 32); }
                bf16* up = U + (size_t)(t0 + tl) * UYP + c0 + 4 * fq;
                u32x2 uu[4];
#pragma unroll
                for (int nt = 0; nt < 4; ++nt) uu[nt] = *(const u32x2*)(up + nt * 16);
                const float bb = P.sgu_b[g * 128 + tl];
                f32x4 acc[4];
#pragma unroll
                for (int nt = 0; nt < 4; ++nt) acc[nt] = (f32x4){0.f, 0.f, 0.f, 0.f};
#pragma unroll
                for (int ks = 0; ks < 4; ++ks)
#pragma unroll
                    for (int nt = 0; nt < 4; ++nt) acc[nt] = __builtin_amdgcn_mfma_f32_16x16x32_bf16(bfr[ks][nt], afr[ks], acc[nt], 0, 0, 0);
#pragma unroll
                for (int nt = 0; nt < 4; ++nt) { const f32x4 gs = *(const f32x4*)(P.g_sgu + c0 + nt * 16 + 4 * fq); const f32x4 a = acc[nt];
                    u32x2 o; o.x = cvtpk(bflo(uu[nt].x) * (gs[0] * a[0] + bb), bfhi(uu[nt].x) * (gs[1] * a[1] + bb)); o.y = cvtpk(bflo(uu[nt].y) * (gs[2] * a[2] + bb), bfhi(uu[nt].y) * (gs[3] * a[3] + bb));
                    *(u32x2*)(up + nt * 16) = o; }
#pragma unroll
                for (int ks = 0; ks < 4; ++ks) afr[ks] = afn[ks];
            }
        }
    }
}

typedef float f32x16 __attribute__((ext_vector_type(16)));
constexpr int VRP = 192;
constexpr int KRP = 144;
template <int G>
__device__ __forceinline__ void attn_qtile(const bf16* __restrict__ Q, const bf16* __restrict__ Kb, const bf16* __restrict__ Vb, bf16* OGg, float* LSEg,
                                           LAS unsigned char* vt, LAS unsigned char* ktl, int b, int h, int r, int m0, int lane) {
    constexpr int d = (G == 0) ? 1 : (G == 1 ? 4 : 16), Mlen = SEQ / d;
    const int j = lane & 31, hi = lane >> 5;
    const float nsl2 = -exp2f(-(float)(h + 1)) * (float)d * 1.4426950408889634f;
    const size_t qpos = (size_t)b * SEQ + (size_t)(m0 + j) * d + r;
    bf16x8_t qf[4];
    { u32x4 qr[4];
#pragma unroll
      for (int q4 = 0; q4 < 4; ++q4) qr[q4] = *(const u32x4*)(Q + ((size_t)b * SEQ + (size_t)(m0 + q4 * 8 + (lane >> 3)) * d + r) * 1536 + G * 512 + h * 64 + (lane & 7) * 8);
      LDS_WAIT();
#pragma unroll
      for (int q4 = 0; q4 < 4; ++q4) *(LAS u32x4*)(ktl + (q4 * 8 + (lane >> 3)) * KRP + (lane & 7) * 16) = qr[q4];
      LDS_WAIT();
#pragma unroll
      for (int ks = 0; ks < 4; ++ks) qf[ks] = *(const LAS bf16x8_t*)(ktl + j * KRP + (2 * ks + hi) * 16);
      LDS_WAIT(); }
    float m_run = -__builtin_inff(), l_run = 0.f;
    f32x16 o0, o1;
#pragma unroll
    for (int i = 0; i < 16; ++i) { o0[i] = 0.f; o1[i] = 0.f; }
    const int trq = (lane & 15) >> 2, trp = lane & 3, blk = (lane >> 4) & 1;
    LAS const unsigned char* trbase = vt + (4 * hi + trq) * VRP + blk * 32 + trp * 8;
#define ATT_LOAD(KR, VR, oi_) do { const int kt_ = 2 + (((oi_) + 1) >> 1) * (((oi_) & 1) ? -1 : 1), kb_ = m0 - 64 + 32 * kt_; \
        _Pragma("unroll") for (int q4 = 0; q4 < 4; ++q4) { int km = kb_ + q4 * 8 + (lane >> 3); km = km < 0 ? 0 : (km >= Mlen ? Mlen - 1 : km); \
            const size_t ro_ = ((size_t)b * SEQ + (size_t)km * d + r) * 512 + h * 64 + (lane & 7) * 8; \
            KR[q4] = *(const u32x4*)(Kb + ro_); VR[q4] = *(const u32x4*)(Vb + ro_); } } while (0)
    u32x4 kr[4], krn[4], vr[4], vrn[4];
    ATT_LOAD(kr, vr, 0);
#pragma unroll 1
    for (int oi = 0; oi < 5; ++oi) {
        const int kt = 2 + ((oi + 1) >> 1) * ((oi & 1) ? -1 : 1);
        const int kb = m0 - 64 + 32 * kt;
        if (oi < 4) ATT_LOAD(krn, vrn, oi + 1);
        LDS_WAIT();
#pragma unroll
        for (int q4 = 0; q4 < 4; ++q4) { *(LAS u32x4*)(ktl + (q4 * 8 + (lane >> 3)) * KRP + (lane & 7) * 16) = kr[q4]; *(LAS u32x4*)(vt + (q4 * 8 + (lane >> 3)) * VRP + (lane & 7) * 16) = vr[q4]; }
        LDS_WAIT();
        bf16x8_t kf[4];
#pragma unroll
        for (int ks = 0; ks < 4; ++ks) kf[ks] = *(const LAS bf16x8_t*)(ktl + j * KRP + (2 * ks + hi) * 16);
        f32x16 sacc;
#pragma unroll
        for (int i = 0; i < 16; ++i) sacc[i] = 0.f;
#pragma unroll
        for (int ks = 0; ks < 4; ++ks) sacc = __builtin_amdgcn_mfma_f32_32x32x16_bf16(kf[ks], qf[ks], sacc, 0, 0, 0);
        const float relbase = (float)(32 * kt - 64 + 4 * hi - j);
        const bool edge = (kb < 0) || (kb + 31 >= Mlen);
        float sv[16]; float tmax = -__builtin_inff();
#pragma unroll
        for (int rr = 0; rr < 16; ++rr) {
            const int ci = (rr & 3) + 8 * (rr >> 2);
            const float arel = fabsf(relbase + (float)ci);
            float s2 = fmaf(arel, nsl2, sacc[rr]);
            s2 = (arel <= 64.0f) ? s2 : -__builtin_inff();
            if (edge) { const int km = kb + ci + 4 * hi; s2 = (km >= 0 && km < Mlen) ? s2 : -__builtin_inff(); }
            sv[rr] = s2; tmax = fmaxf(tmax, s2);
        }
        tmax = fmaxf(tmax, __shfl_xor(tmax, 32));
        const float m_new = fmaxf(m_run, tmax);
        const float alpha = __builtin_amdgcn_exp2f(m_run - m_new);
        m_run = m_new;
        float lsum = 0.f;
#pragma unroll
        for (int rr = 0; rr < 16; ++rr) { sv[rr] = __builtin_amdgcn_exp2f(sv[rr] - m_new); lsum += sv[rr]; }
        l_run = l_run * alpha + lsum;
#pragma unroll
        for (int i = 0; i < 16; ++i) { o0[i] *= alpha; o1[i] *= alpha; }
        bf16x8_t pb[2];
#pragma unroll
        for (int s2i = 0; s2i < 2; ++s2i) { u32x4 w; w.x = cvtpk(sv[8 * s2i], sv[8 * s2i + 1]); w.y = cvtpk(sv[8 * s2i + 2], sv[8 * s2i + 3]); w.z = cvtpk(sv[8 * s2i + 4], sv[8 * s2i + 5]); w.w = cvtpk(sv[8 * s2i + 6], sv[8 * s2i + 7]);
            pb[s2i] = __builtin_bit_cast(bf16x8_t, w); }
#pragma unroll
        for (int s2i = 0; s2i < 2; ++s2i) {
#pragma unroll
            for (int c = 0; c < 2; ++c) {
                const s16x4_t lo = lds_tr16(trbase + (16 * s2i) * VRP + c * 64);
                const s16x4_t hh = lds_tr16(trbase + (16 * s2i + 8) * VRP + c * 64);
                const bf16x8_t vf = (bf16x8_t){lo[0], lo[1], lo[2], lo[3], hh[0], hh[1], hh[2], hh[3]};
                if (c == 0) o0 = __builtin_amdgcn_mfma_f32_32x32x16_bf16(vf, pb[s2i], o0, 0, 0, 0);
                else o1 = __builtin_amdgcn_mfma_f32_32x32x16_bf16(vf, pb[s2i], o1, 0, 0, 0);
            }
        }
#pragma unroll
        for (int i = 0; i < 4; ++i) { kr[i] = krn[i]; vr[i] = vrn[i]; }
    }
#undef ATT_LOAD
    const float l_tot = l_run + __shfl_xor(l_run, 32);
    const float inv = 1.0f / l_tot;
    LDS_WAIT();
#pragma unroll
    for (int g4 = 0; g4 < 4; ++g4) {
        u32x2 w0, w1;
        w0.x = cvtpk(o0[4 * g4] * inv, o0[4 * g4 + 1] * inv); w0.y = cvtpk(o0[4 * g4 + 2] * inv, o0[4 * g4 + 3] * inv);
        w1.x = cvtpk(o1[4 * g4] * inv, o1[4 * g4 + 1] * inv); w1.y = cvtpk(o1[4 * g4 + 2] * inv, o1[4 * g4 + 3] * inv);
        *(LAS u32x2*)(ktl + j * KRP + (8 * g4 + 4 * hi) * 2) = w0; *(LAS u32x2*)(ktl + j * KRP + (32 + 8 * g4 + 4 * hi) * 2) = w1;
    }
    LDS_WAIT();
#pragma unroll
    for (int q4 = 0; q4 < 4; ++q4) { const int jr = q4 * 8 + (lane >> 3);
        const u32x4 v = *(const LAS u32x4*)(ktl + jr * KRP + (lane & 7) * 16);
        *(u32x4*)(OGg + ((size_t)b * SEQ + (size_t)(m0 + jr) * d + r) * 512 + h * 64 + (lane & 7) * 8) = v; }
    if (hi == 0) LSEg[((size_t)b * 8 + h) * SEQ + (size_t)(m0 + j) * d + r] = m_run + __builtin_amdgcn_logf(l_tot);
}
struct AttnSt { float m, l; f32x16 o0, o1; };
__device__ __forceinline__ float xhalf_max(float v) { const auto r = __builtin_amdgcn_permlane32_swap(__float_as_uint(v), __float_as_uint(v), false, false); return fmaxf(__uint_as_float(r[0]), __uint_as_float(r[1])); }
__device__ __forceinline__ float xhalf_sum(float v) { const auto r = __builtin_amdgcn_permlane32_swap(__float_as_uint(v), __float_as_uint(v), false, false); return __uint_as_float(r[0]) + __uint_as_float(r[1]); }
constexpr float RESCALE_THR = 8.0f;
template <int G>
__device__ __forceinline__ void attn_tile_update(AttnSt& st, const bf16x8_t (&qf)[4], const bf16x8_t (&kf)[4], const bf16x8_t (&vf)[2][2], int kt, int kb, int j, int hi, float nsl2) {
    constexpr int d = (G == 0) ? 1 : (G == 1 ? 4 : 16), Mlen = SEQ / d;
    f32x16 sacc;
#pragma unroll
    for (int i = 0; i < 16; ++i) sacc[i] = 0.f;
#pragma unroll
    for (int ks = 0; ks < 4; ++ks) sacc = __builtin_amdgcn_mfma_f32_32x32x16_bf16(kf[ks], qf[ks], sacc, 0, 0, 0);
    float relbase = (float)(32 * kt - 64 + 4 * hi - j);
    asm volatile("" : "+v"(relbase));
    const bool edge = (kb < 0) || (kb + 31 >= Mlen);
    float sv[16]; float tmax = -__builtin_inff();
#pragma unroll
    for (int rr = 0; rr < 16; ++rr) { const int ci = (rr & 3) + 8 * (rr >> 2); sv[rr] = fmaf(fabsf(relbase + (float)ci), nsl2, sacc[rr]); }
    if (kt == 0 || kt == 4) {
        asm volatile("" : "+v"(relbase));
#pragma unroll
        for (int rr = 0; rr < 16; ++rr) { const int ci = (rr & 3) + 8 * (rr >> 2); sv[rr] = (fabsf(relbase + (float)ci) <= 64.0f) ? sv[rr] : -__builtin_inff(); }
    }
    if (edge) {
        int kbl = kb + 4 * hi; asm volatile("" : "+v"(kbl));
#pragma unroll
        for (int rr = 0; rr < 16; ++rr) { const int km = kbl + (rr & 3) + 8 * (rr >> 2); sv[rr] = (km >= 0 && km < Mlen) ? sv[rr] : -__builtin_inff(); }
    }
#pragma unroll
    for (int rr = 0; rr < 16; ++rr) tmax = fmaxf(tmax, sv[rr]);
    tmax = xhalf_max(tmax);
    if (!__all(tmax - st.m <= RESCALE_THR)) {
        const float m_new = fmaxf(st.m, tmax);
        const float alpha = __builtin_amdgcn_exp2f(st.m - m_new);
        st.m = m_new; st.l *= alpha;
#pragma unroll
        for (int i = 0; i < 16; ++i) { st.o0[i] *= alpha; st.o1[i] *= alpha; }
    }
    const float mcur = st.m;
    float lsum = 0.f;
#pragma unroll
    for (int rr = 0; rr < 16; ++rr) { sv[rr] = __builtin_amdgcn_exp2f(sv[rr] - mcur); lsum += sv[rr]; }
    st.l += lsum;
#pragma unroll
    for (int s2i = 0; s2i < 2; ++s2i) { u32x4 w; w.x = cvtpk(sv[8 * s2i], sv[8 * s2i + 1]); w.y = cvtpk(sv[8 * s2i + 2], sv[8 * s2i + 3]); w.z = cvtpk(sv[8 * s2i + 4], sv[8 * s2i + 5]); w.w = cvtpk(sv[8 * s2i + 6], sv[8 * s2i + 7]);
        const bf16x8_t pb = __builtin_bit_cast(bf16x8_t, w);
        st.o0 = __builtin_amdgcn_mfma_f32_32x32x16_bf16(vf[s2i][0], pb, st.o0, 0, 0, 0);
        st.o1 = __builtin_amdgcn_mfma_f32_32x32x16_bf16(vf[s2i][1], pb, st.o1, 0, 0, 0); }
}
__device__ __forceinline__ f32x16 attn_qk(const bf16x8_t (&qf)[4], const bf16x8_t (&kf)[4]) {
    f32x16 sacc;
#pragma unroll
    for (int i = 0; i < 16; ++i) sacc[i] = 0.f;
#pragma unroll
    for (int ks = 0; ks < 4; ++ks) sacc = __builtin_amdgcn_mfma_f32_32x32x16_bf16(kf[ks], qf[ks], sacc, 0, 0, 0);
    return sacc;
}
template <int G>
__device__ __forceinline__ void attn_sm(AttnSt& st, const f32x16& sacc, bf16x8_t (&pb)[2], int kt, int kb, int j, int hi, float nsl2) {
    constexpr int d = (G == 0) ? 1 : (G == 1 ? 4 : 16), Mlen = SEQ / d;
    float relbase = (float)(32 * kt - 64 + 4 * hi - j);
    asm volatile("" : "+v"(relbase));
    const bool edge = (kb < 0) || (kb + 31 >= Mlen);
    float sv[16]; float tmax = -__builtin_inff();
#pragma unroll
    for (int rr = 0; rr < 16; ++rr) { const int ci = (rr & 3) + 8 * (rr >> 2); sv[rr] = fmaf(fabsf(relbase + (float)ci), nsl2, sacc[rr]); }
    if (kt == 0 || kt == 4) {
        asm volatile("" : "+v"(relbase));
#pragma unroll
        for (int rr = 0; rr < 16; ++rr) { const int ci = (rr & 3) + 8 * (rr >> 2); sv[rr] = (fabsf(relbase + (float)ci) <= 64.0f) ? sv[rr] : -__builtin_inff(); }
    }
    if (edge) {
        int kbl = kb + 4 * hi; asm volatile("" : "+v"(kbl));
#pragma unroll
        for (int rr = 0; rr < 16; ++rr) { const int km = kbl + (rr & 3) + 8 * (rr >> 2); sv[rr] = (km >= 0 && km < Mlen) ? sv[rr] : -__builtin_inff(); }
    }
#pragma unroll
    for (int rr = 0; rr < 16; ++rr) tmax = fmaxf(tmax, sv[rr]);
    tmax = xhalf_max(tmax);
    if (!__all(tmax - st.m <= RESCALE_THR)) {
        const float m_new = fmaxf(st.m, tmax);
        const float alpha = __builtin_amdgcn_exp2f(st.m - m_new);
        st.m = m_new; st.l *= alpha;
#pragma unroll
        for (int i = 0; i < 16; ++i) { st.o0[i] *= alpha; st.o1[i] *= alpha; }
    }
    const float mcur = st.m;
    float lsum = 0.f;
#pragma unroll
    for (int rr = 0; rr < 16; ++rr) { sv[rr] = __builtin_amdgcn_exp2f(sv[rr] - mcur); lsum += sv[rr]; }
    st.l += lsum;
#pragma unroll
    for (int s2i = 0; s2i < 2; ++s2i) { u32x4 w; w.x = cvtpk(sv[8 * s2i], sv[8 * s2i + 1]); w.y = cvtpk(sv[8 * s2i + 2], sv[8 * s2i + 3]); w.z = cvtpk(sv[8 * s2i + 4], sv[8 * s2i + 5]); w.w = cvtpk(sv[8 * s2i + 6], sv[8 * s2i + 7]);
        pb[s2i] = __builtin_bit_cast(bf16x8_t, w); }
}
__device__ __forceinline__ void attn_pv(AttnSt& st, const bf16x8_t (&pb)[2], const bf16x8_t (&vf)[2][2]) {
#pragma unroll
    for (int s2i = 0; s2i < 2; ++s2i) {
        st.o0 = __builtin_amdgcn_mfma_f32_32x32x16_bf16(vf[s2i][0], pb[s2i], st.o0, 0, 0, 0);
        st.o1 = __builtin_amdgcn_mfma_f32_32x32x16_bf16(vf[s2i][1], pb[s2i], st.o1, 0, 0, 0); }
}
template <int G>
__device__ __forceinline__ void attn_qpair(const bf16* __restrict__ Q, const bf16* __restrict__ Kb, const bf16* __restrict__ Vb, bf16* OGg, float* LSEg,
                                           LAS unsigned char* vt, LAS unsigned char* ktl, int b, int h, int r, int m0, int lane) {
    constexpr int d = (G == 0) ? 1 : (G == 1 ? 4 : 16), Mlen = SEQ / d;
    asm volatile("" : "+v"(lane));
    const int j = lane & 31, hi = lane >> 5;
    const float nsl2 = -exp2f(-(float)(h + 1)) * (float)d * 1.4426950408889634f;
#define ATT_KTP(oi_) (((oi_) & 1) ? 3 + ((oi_) >> 1) : 2 - ((oi_) >> 1))
#define ATT_LOAD2(KR, VR, ktp_) do { const int kb_ = m0 - 64 + 32 * (ktp_); \
        _Pragma("unroll") for (int q4 = 0; q4 < 4; ++q4) { int km = kb_ + q4 * 8 + (lane >> 3); km = km < 0 ? 0 : (km >= Mlen ? Mlen - 1 : km); \
            const size_t ro_ = ((size_t)b * SEQ + (size_t)km * d + r) * 512 + h * 64 + (lane & 7) * 8; \
            KR[q4] = *(const u32x4*)(Kb + ro_); VR[q4] = *(const u32x4*)(Vb + ro_); } } while (0)
    bf16x8_t qfA[4], qfB[4];
    u32x4 kr[4], vr[4];
    { u32x4 qa[4], qb[4];
#pragma unroll
      for (int q4 = 0; q4 < 4; ++q4) qa[q4] = __builtin_nontemporal_load((const u32x4*)(Q + ((size_t)b * SEQ + (size_t)(m0 + q4 * 8 + (lane >> 3)) * d + r) * 1536 + G * 512 + h * 64 + (lane & 7) * 8));
#pragma unroll
      for (int q4 = 0; q4 < 4; ++q4) qb[q4] = __builtin_nontemporal_load((const u32x4*)(Q + ((size_t)b * SEQ + (size_t)(m0 + 32 + q4 * 8 + (lane >> 3)) * d + r) * 1536 + G * 512 + h * 64 + (lane & 7) * 8));
      ATT_LOAD2(kr, vr, 2);
      LDS_WAIT();
#pragma unroll
      for (int q4 = 0; q4 < 4; ++q4) { *(LAS u32x4*)(ktl + (q4 * 8 + (lane >> 3)) * KRP + (lane & 7) * 16) = qa[q4]; *(LAS u32x4*)(vt + (q4 * 8 + (lane >> 3)) * VRP + (lane & 7) * 16) = qb[q4]; }
      LDS_WAIT();
#pragma unroll
      for (int ks = 0; ks < 4; ++ks) { qfA[ks] = *(const LAS bf16x8_t*)(ktl + j * KRP + (2 * ks + hi) * 16); qfB[ks] = *(const LAS bf16x8_t*)(vt + j * VRP + (2 * ks + hi) * 16); }
      LDS_WAIT(); }
    AttnSt A, B;
    A.m = -__builtin_inff(); A.l = 0.f; B.m = -__builtin_inff(); B.l = 0.f;
#pragma unroll
    for (int i = 0; i < 16; ++i) { A.o0[i] = 0.f; A.o1[i] = 0.f; B.o0[i] = 0.f; B.o1[i] = 0.f; }
    const int trq = (lane & 15) >> 2, trp = lane & 3, blk = (lane >> 4) & 1;
    LAS const unsigned char* trbase = vt + (4 * hi + trq) * VRP + blk * 32 + trp * 8;
#define ATT_STAGE(oi_) \
        LDS_WAIT(); \
        _Pragma("unroll") for (int q4 = 0; q4 < 4; ++q4) { *(LAS u32x4*)(ktl + (q4 * 8 + (lane >> 3)) * KRP + (lane & 7) * 16) = kr[q4]; *(LAS u32x4*)(vt + (q4 * 8 + (lane >> 3)) * VRP + (lane & 7) * 16) = vr[q4]; } \
        if ((oi_) < 5) ATT_LOAD2(kr, vr, ATT_KTP((oi_) + 1)); \
        LDS_WAIT(); \
        bf16x8_t kf[4]; bf16x8_t vf[2][2]; \
        _Pragma("unroll") for (int ks = 0; ks < 4; ++ks) kf[ks] = *(const LAS bf16x8_t*)(ktl + j * KRP + (2 * ks + hi) * 16); \
        _Pragma("unroll") for (int s2i = 0; s2i < 2; ++s2i) _Pragma("unroll") for (int c = 0; c < 2; ++c) { \
            const s16x4_t lo = lds_tr16(trbase + (16 * s2i) * VRP + c * 64); const s16x4_t hh = lds_tr16(trbase + (16 * s2i + 8) * VRP + c * 64); \
            vf[s2i][c] = (bf16x8_t){lo[0], lo[1], lo[2], lo[3], hh[0], hh[1], hh[2], hh[3]}; }
#pragma unroll 1
    for (int oi = 0; oi < 4; ++oi) {
        const int ktp = ATT_KTP(oi), kb = m0 - 64 + 32 * ktp;
        ATT_STAGE(oi)
        const f32x16 sA = attn_qk(qfA, kf); const f32x16 sB = attn_qk(qfB, kf);
        __builtin_amdgcn_sched_barrier(0);
        bf16x8_t pA[2], pB[2];
        attn_sm<G>(A, sA, pA, ktp, kb, j, hi, nsl2);
        __builtin_amdgcn_sched_barrier(0);
        attn_pv(A, pA, vf);
        attn_sm<G>(B, sB, pB, ktp - 1, kb, j, hi, nsl2);
        __builtin_amdgcn_sched_barrier(0);
        attn_pv(B, pB, vf);
    }
    { const int kb = m0 - 64;
      ATT_STAGE(4)
      attn_tile_update<G>(A, qfA, kf, vf, 0, kb, j, hi, nsl2); }
    { const int kb = m0 - 64 + 160;
      ATT_STAGE(5)
      attn_tile_update<G>(B, qfB, kf, vf, 4, kb, j, hi, nsl2); }
#undef ATT_STAGE
#undef ATT_LOAD2
#undef ATT_KTP
#define ATT_FIN(ST, mq) do { const float l_tot = xhalf_sum(ST.l); const float inv = 1.0f / l_tot; \
      LDS_WAIT(); \
      _Pragma("unroll") for (int g4 = 0; g4 < 4; ++g4) { u32x2 w0, w1; \
        w0.x = cvtpk(ST.o0[4 * g4] * inv, ST.o0[4 * g4 + 1] * inv); w0.y = cvtpk(ST.o0[4 * g4 + 2] * inv, ST.o0[4 * g4 + 3] * inv); \
        w1.x = cvtpk(ST.o1[4 * g4] * inv, ST.o1[4 * g4 + 1] * inv); w1.y = cvtpk(ST.o1[4 * g4 + 2] * inv, ST.o1[4 * g4 + 3] * inv); \
        *(LAS u32x2*)(ktl + j * KRP + (8 * g4 + 4 * hi) * 2) = w0; *(LAS u32x2*)(ktl + j * KRP + (32 + 8 * g4 + 4 * hi) * 2) = w1; } \
      LDS_WAIT(); \
      _Pragma("unroll") for (int q4 = 0; q4 < 4; ++q4) { const int jr = q4 * 8 + (lane >> 3); \
        const u32x4 v = *(const LAS u32x4*)(ktl + jr * KRP + (lane & 7) * 16); \
        *(u32x4*)(OGg + ((size_t)b * SEQ + (size_t)((mq) + jr) * d + r) * 512 + h * 64 + (lane & 7) * 8) = v; } \
      if (hi == 0) LSEg[((size_t)b * 8 + h) * SEQ + (size_t)((mq) + j) * d + r] = ST.m + __builtin_amdgcn_logf(l_tot); } while (0)
    ATT_FIN(A, m0); ATT_FIN(B, m0 + 32);
#undef ATT_FIN
}
__device__ __forceinline__ void p2_attn_mfma(const Params& P, LAS unsigned char* lds, int wave, int lane) {
    unsigned char* ws = P.ws;
    const bf16* Q = (const bf16*)(ws + WS_Q); const bf16* Kb = (const bf16*)(ws + WS_K); const bf16* Vb = (const bf16*)(ws + WS_V);
    bf16* YB = (bf16*)(ws + WS_UY) + 1024;
    bf16* OG = (bf16*)((unsigned char*)P.out + 32 * MiB);
    float* LSE = (float*)(ws + WS_LSE);
    LAS unsigned char* vt = lds + wave * (32 * VRP + 32 * KRP); LAS unsigned char* ktl = vt + 32 * VRP;
    for (int unit = blockIdx.x; unit < BATCH * 8 * (SEQ / 1024); unit += gridDim.x) {
        const int b = unit >> 6, h = (unit >> 3) & 7, s0 = (unit & 7) * 1024;
#pragma unroll 1
        for (int i = 0; i < 4; i += 2) { const int ti = wave * 4 + i;
            attn_qpair<0>(Q, Kb, Vb, OG, LSE, vt, ktl, b, h, 0, s0 + ti * 32, lane); }
#pragma unroll 1
        for (int i = 0; i < 4; i += 2) { const int ti = wave * 4 + i;
            attn_qpair<1>(Q, Kb, Vb, OG + (size_t)T * 512, LSE + (size_t)T * 8, vt, ktl, b, h, ti >> 3, s0 / 4 + (ti & 7) * 32, lane); }
#pragma unroll 1
        for (int i = 0; i < 4; i += 2) { const int ti = wave * 4 + i;
            attn_qpair<2>(Q, Kb, Vb, OG + (size_t)2 * T * 512, LSE + (size_t)2 * T * 8, vt, ktl, b, h, ti >> 1, s0 / 16 + (ti & 1) * 32, lane); }
        __syncthreads();
        for (int idx = threadIdx.x; idx < 1024 * 8; idx += NTHR) {
            const int tok = idx >> 3, chn = idx & 7; const size_t t = (size_t)b * SEQ + s0 + tok;
            const size_t li = ((size_t)b * 8 + h) * SEQ + s0 + tok;
            const float l0 = LSE[li], l1 = LSE[(size_t)T * 8 + li], l2 = LSE[(size_t)2 * T * 8 + li];
            const float mx = fmaxf(l0, fmaxf(l1, l2));
            float w0 = __builtin_amdgcn_exp2f(l0 - mx), w1 = __builtin_amdgcn_exp2f(l1 - mx), w2 = __builtin_amdgcn_exp2f(l2 - mx);
            const float inv = 1.0f / (w0 + w1 + w2); w0 *= inv; w1 *= inv; w2 *= inv;
            const size_t off = t * 512 + h * 64 + chn * 8;
            const u32x4 a = *(const u32x4*)(OG + off), bb = *(const u32x4*)(OG + (size_t)T * 512 + off), c = *(const u32x4*)(OG + (size_t)2 * T * 512 + off);
            u32x4 o;
            o.x = cvtpk(w0 * bflo(a.x) + w1 * bflo(bb.x) + w2 * bflo(c.x), w0 * bfhi(a.x) + w1 * bfhi(bb.x) + w2 * bfhi(c.x));
            o.y = cvtpk(w0 * bflo(a.y) + w1 * bflo(bb.y) + w2 * bflo(c.y), w0 * bfhi(a.y) + w1 * bfhi(bb.y) + w2 * bfhi(c.y));
            o.z = cvtpk(w0 * bflo(a.z) + w1 * bflo(bb.z) + w2 * bflo(c.z), w0 * bfhi(a.z) + w1 * bfhi(bb.z) + w2 * bfhi(c.z));
            o.w = cvtpk(w0 * bflo(a.w) + w1 * bflo(bb.w) + w2 * bflo(c.w), w0 * bfhi(a.w) + w1 * bfhi(bb.w) + w2 * bfhi(c.w));
            *(u32x4*)(YB + t * UYP + h * 64 + chn * 8) = o;
        }
        __syncthreads();
    }
}

__device__ __forceinline__ float sel4f(bool b0, bool b1, float a, float b, float c, float d) { const float lo = b0 ? b : a, hi = b0 ? d : c; return b1 ? hi : lo; }
__device__ __forceinline__ unsigned sel4u(bool b0, bool b1, unsigned a, unsigned b, unsigned c, unsigned d) { const unsigned lo = b0 ? b : a, hi = b0 ? d : c; return b1 ? hi : lo; }
#define CE_D(a, b) do { const float hi_ = fmaxf(a, b), lo_ = fminf(a, b); a = hi_; b = lo_; } while (0)
__device__ __forceinline__ void bitonic_merge16(float (&v)[16]) {
#pragma unroll
    for (int js = 3; js >= 0; --js) { const int j = 1 << js;
#pragma unroll
        for (int i = 0; i < 16; ++i) { const int l = i ^ j; if (l > i) CE_D(v[i], v[l]); } }
}
__device__ __forceinline__ void bitonic_sort16(float (&v)[16]) {
    CE_D(v[0], v[13]); CE_D(v[1], v[12]); CE_D(v[2], v[15]); CE_D(v[3], v[14]); CE_D(v[4], v[8]); CE_D(v[5], v[6]); CE_D(v[7], v[11]); CE_D(v[9], v[10]);
    CE_D(v[0], v[5]); CE_D(v[1], v[7]); CE_D(v[2], v[9]); CE_D(v[3], v[4]); CE_D(v[6], v[13]); CE_D(v[8], v[14]); CE_D(v[10], v[15]); CE_D(v[11], v[12]);
    CE_D(v[0], v[1]); CE_D(v[2], v[3]); CE_D(v[4], v[5]); CE_D(v[6], v[8]); CE_D(v[7], v[9]); CE_D(v[10], v[11]); CE_D(v[12], v[13]); CE_D(v[14], v[15]);
    CE_D(v[0], v[2]); CE_D(v[1], v[3]); CE_D(v[4], v[10]); CE_D(v[5], v[11]); CE_D(v[6], v[7]); CE_D(v[8], v[9]); CE_D(v[12], v[14]); CE_D(v[13], v[15]);
    CE_D(v[1], v[2]); CE_D(v[3], v[12]); CE_D(v[4], v[6]); CE_D(v[5], v[7]); CE_D(v[8], v[10]); CE_D(v[9], v[11]); CE_D(v[13], v[14]); CE_D(v[1], v[4]);
    CE_D(v[2], v[6]); CE_D(v[5], v[8]); CE_D(v[7], v[10]); CE_D(v[9], v[13]); CE_D(v[11], v[14]); CE_D(v[2], v[4]); CE_D(v[3], v[6]); CE_D(v[9], v[12]);
    CE_D(v[11], v[13]); CE_D(v[3], v[5]); CE_D(v[6], v[8]); CE_D(v[7], v[9]); CE_D(v[10], v[12]); CE_D(v[3], v[4]); CE_D(v[5], v[6]); CE_D(v[7], v[8]);
    CE_D(v[9], v[10]); CE_D(v[11], v[12]); CE_D(v[6], v[7]); CE_D(v[8], v[9]);
}
__device__ __forceinline__ void xlane_top16(float (&c)[16], int o) {
    float tmp[16];
#pragma unroll
    for (int i = 0; i < 16; ++i) tmp[i] = __shfl_xor(c[15 - i], o);
#pragma unroll
    for (int i = 0; i < 16; ++i) c[i] = fmaxf(c[i], tmp[i]);
    bitonic_merge16(c);
}
__device__ __forceinline__ float pk_idx(float x, unsigned n) { return __uint_as_float((__float_as_uint(x) & ~127u) | n); }
constexpr int SKP = 272;
template <int MODE>
__device__ __forceinline__ void p6_topk_mfma(const Params& P, LAS unsigned char* lds, int wave, int lane) {
    unsigned char* ws = P.ws;
    const bf16* PQ = (const bf16*)(ws + WS_SG); const bf16* SK = (const bf16*)(ws + WS_SUBK); const float* SS2 = (const float*)(ws + WS_SS2);
    int* EI = MODE ? (int*)(ws + WS_UY + 32 * MiB) : (int*)(ws + WS_K); float* EG = MODE ? (float*)(ws + WS_UY + 48 * MiB) : (float*)(ws + WS_V);
    float* ES = (float*)(ws + WS_K + 16 * MiB); float* RSTD2 = (float*)(ws + WS_RSTD1 + 512 * 1024); const f32x2* UVQ = (const f32x2*)(ws + WS_UT + 4 * SLICE_BYTES);
    const int fr = lane & 15, fq = lane >> 4; const bool q0 = (fq & 1) != 0, q1 = (fq & 2) != 0;
    const float NEG = -__builtin_inff();
    constexpr int GI[4][13] = {{0,0,0,0,0,0,0,0,0,0,0,0,0}, {1,1,1,1,1,1,1,1,2,2,2,2,2}, {3,3,3,3,4,4,4,5,5,6,6,7,7}, {0,0,0,8,9,10,11,12,13,14,15,0,0}};
    constexpr int GJ[4][13] = {{0,1,2,3,4,5,6,7,8,9,10,11,12}, {0,1,2,3,4,5,6,7,0,1,2,3,4}, {0,1,2,3,0,1,2,0,1,0,1,0,1}, {13,14,15,0,0,0,0,0,0,0,0,0,0}};
    LAS unsigned char* sk = lds;
    LAS float* lut = (LAS float*)(lds + 2 * 128 * SKP + wave * 2048);
    for (int tile0 = blockIdx.x * NWAVES; tile0 < T / 16; tile0 += gridDim.x * NWAVES) {
        const int tile = tile0 + wave; const bool active = tile < T / 16; const int t = (active ? tile : 0) * 16 + fr;
        float rstd2;
        { const f32x4* sp = (const f32x4*)(SS2 + (size_t)t * 16); const f32x4 a = sp[0], b = sp[1], c = sp[2], d = sp[3];
          rstd2 = rsqrtf((((a[0] + a[1]) + (a[2] + a[3])) + ((b[0] + b[1]) + (b[2] + b[3])) + ((c[0] + c[1]) + (c[2] + c[3])) + ((d[0] + d[1]) + (d[2] + d[3]))) * (1.0f / D) + EPS); }
        if (MODE == 0 && active && fq == 0) RSTD2[t] = rstd2;
        u32x4 pid = {0u, 0u, 0u, 0u}; f32x4 pgate = {0.f, 0.f, 0.f, 0.f}; f32x2 psc[4] = {{0.f, 0.f}, {0.f, 0.f}, {0.f, 0.f}, {0.f, 0.f}};
#define P6_FLUSH(hh) do { if (active) { const size_t o_ = (size_t)t * 128 + (hh) * 16 + 4 * fq; *(u32x4*)(EI + o_) = pid; \
            *(f32x4*)(EG + o_) = (f32x4){pgate[0] * psc[0].y, pgate[1] * psc[1].y, pgate[2] * psc[2].y, pgate[3] * psc[3].y}; *(f32x4*)(ES + o_) = (f32x4){psc[0].x, psc[1].x, psc[2].x, psc[3].x}; } } while (0)
        u32x4 skr[8];
#pragma unroll
        for (int q = 0; q < 8; ++q) { const int i = threadIdx.x + q * NTHR; skr[q] = *(const u32x4*)(SK + ((size_t)(i >> 4)) * 128 + (i & 15) * 8); }
        bf16x8_t qn[4];
#pragma unroll
        for (int ks = 0; ks < 4; ++ks) qn[ks] = __builtin_nontemporal_load((const bf16x8_t*)(PQ + ((size_t)(t >> 4) * 64 + ks) * 512 + (fq * 16 + fr) * 8));
#pragma unroll 1
        for (int h = 0; h < 8; ++h) {
            __syncthreads();
#pragma unroll
            for (int q = 0; q < 8; ++q) { const int i = threadIdx.x + q * NTHR; *(LAS u32x4*)(sk + (i >> 4) * SKP + (i & 15) * 16) = skr[q]; }
            __syncthreads();
            if (h < 7) {
#pragma unroll
                for (int q = 0; q < 8; ++q) { const int i = threadIdx.x + q * NTHR; skr[q] = *(const u32x4*)(SK + ((size_t)(h + 1) * 256 + (i >> 4)) * 128 + (i & 15) * 8); } }
            if (MODE == 2) continue;
            if (MODE == 0 && h > 0) P6_FLUSH(h - 1);
            float top[2][16];
#pragma unroll
            for (int p = 0; p < 2; ++p) {
                f32x4 acc[8];
#pragma unroll
                for (int nt = 0; nt < 8; ++nt) acc[nt] = (f32x4){0.f, 0.f, 0.f, 0.f};
#pragma unroll
                for (int ks = 0; ks < 4; ++ks) {
                    const bf16x8_t qf = qn[ks];
#pragma unroll
                    for (int nt = 0; nt < 8; ++nt) {
                        const bf16x8_t kf = *(const LAS bf16x8_t*)(sk + (p * 128 + nt * 16 + fr) * SKP + ks * 64 + fq * 16);
                        acc[nt] = __builtin_amdgcn_mfma_f32_16x16x32_bf16(kf, qf, acc[nt], 0, 0, 0); }
                }
                { const int nb = (h * 2 + p + 1) & 15;
#pragma unroll
                  for (int ks = 0; ks < 4; ++ks) qn[ks] = __builtin_nontemporal_load((const bf16x8_t*)(PQ + ((size_t)(t >> 4) * 64 + nb * 4 + ks) * 512 + (fq * 16 + fr) * 8)); }
                float a[16], b[16];
#pragma unroll
                for (int nt = 0; nt < 4; ++nt)
#pragma unroll
                    for (int r = 0; r < 4; ++r) { a[nt * 4 + r] = pk_idx(acc[nt][r], (unsigned)(nt * 16 + 4 * fq + r)); b[nt * 4 + r] = pk_idx(acc[nt + 4][r], (unsigned)((nt + 4) * 16 + 4 * fq + r)); }
                if (MODE == 1) { float keep = 0.f;
#pragma unroll
                    for (int i = 0; i < 16; ++i) keep += a[i] + b[i];
#pragma unroll
                    for (int i = 0; i < 16; ++i) top[p][i] = keep; continue; }
                bitonic_sort16(a); bitonic_sort16(b);
#pragma unroll
                for (int i = 0; i < 16; ++i) a[i] = fmaxf(a[i], b[15 - i]);
                bitonic_merge16(a);
                xlane_top16(a, 16); xlane_top16(a, 32);
#pragma unroll
                for (int i = 0; i < 16; ++i) top[p][i] = a[i];
            }
            if (MODE == 1) { if (active && fq == 0) EG[(size_t)t * 128 + h] = top[0][0] + top[1][0]; continue; }
            { f32x4 w0, w1;
#pragma unroll
              for (int r = 0; r < 4; ++r) { w0[r] = sel4f(q0, q1, top[0][r], top[0][4 + r], top[0][8 + r], top[0][12 + r]);
                                            w1[r] = sel4f(q0, q1, top[1][r], top[1][4 + r], top[1][8 + r], top[1][12 + r]); }
              *(LAS f32x4*)(lut + fr * 32 + 4 * fq) = w0; *(LAS f32x4*)(lut + fr * 32 + 16 + 4 * fq) = w1; }
            float cv[16];
#pragma unroll
            for (int sl = 0; sl < 13; ++sl) {
                const float av = sel4f(q0, q1, top[0][GI[0][sl]], top[0][GI[1][sl]], top[0][GI[2][sl]], top[0][GI[3][sl]]);
                const float bv = sel4f(q0, q1, top[1][GJ[0][sl]], top[1][GJ[1][sl]], top[1][GJ[2][sl]], top[1][GJ[3][sl]]);
                const unsigned code = sel4u(q0, q1, (unsigned)(GI[0][sl] * 16 + GJ[0][sl]), (unsigned)(GI[1][sl] * 16 + GJ[1][sl]), (unsigned)(GI[2][sl] * 16 + GJ[2][sl]), (unsigned)(GI[3][sl] * 16 + GJ[3][sl]));
                const float sm = __uint_as_float(__float_as_uint(av) & ~127u) + __uint_as_float(__float_as_uint(bv) & ~127u);
                const bool pad = (sl >= 11) && (fq == 3);
                cv[sl] = pad ? NEG : __uint_as_float((__float_as_uint(sm) & ~255u) | code);
            }
            cv[13] = NEG; cv[14] = NEG; cv[15] = NEG;
            bitonic_sort16(cv);
            xlane_top16(cv, 16); xlane_top16(cv, 32);
            float wv[4];
#pragma unroll
            for (int r = 0; r < 4; ++r) wv[r] = sel4f(q0, q1, cv[r], cv[4 + r], cv[8 + r], cv[12 + r]);
            LDS_WAIT();
            const float sc2 = rstd2 * 1.4426950408889634f; const float wmax = __uint_as_float(__float_as_uint(cv[0]) & ~255u);
            u32x4 ids; f32x4 ex; float part = 0.f;
#pragma unroll
            for (int r = 0; r < 4; ++r) { const unsigned bits = __float_as_uint(wv[r]); const unsigned ci = (bits >> 4) & 15u, cj = bits & 15u;
                const unsigned ia = __float_as_uint(lut[fr * 32 + ci]) & 127u, ib = __float_as_uint(lut[fr * 32 + 16 + cj]) & 127u;
                ids[r] = (ia << 7) | ib;
                ex[r] = __builtin_amdgcn_exp2f((__uint_as_float(bits & ~255u) - wmax) * sc2); part += ex[r]; }
            part += __shfl_xor(part, 16); part += __shfl_xor(part, 32);
            const float inv = 1.0f / part;
            pid = ids; pgate = ex * inv;
#pragma unroll
            for (int r = 0; r < 4; ++r) psc[r] = UVQ[ids[r]];
            LDS_WAIT();
        }
        if (MODE == 0) P6_FLUSH(7);
#undef P6_FLUSH
    }
}

__device__ __forceinline__ float dot2bf(unsigned a, unsigned b, float acc) {
    return __builtin_amdgcn_fdot2_f32_bf16(__builtin_bit_cast(bf16x2_t, a), __builtin_bit_cast(bf16x2_t, b), acc, false);
}
__device__ __forceinline__ float dot8(const u32x4& a, const u32x4& b, float acc) {
    const unsigned a0 = a.x, a1 = a.y, a2 = a.z, a3 = a.w, b0 = b.x, b1 = b.y, b2 = b.z, b3 = b.w;
    acc = dot2bf(a0, b0, acc); acc = dot2bf(a1, b1, acc); acc = dot2bf(a2, b2, acc); acc = dot2bf(a3, b3, acc);
    return acc;
}
__device__ __forceinline__ void axpy8(float (&o)[8], float a, const u32x4& v) {
    o[0] = fmaf(a, bflo(v.x), o[0]); o[1] = fmaf(a, bfhi(v.x), o[1]); o[2] = fmaf(a, bflo(v.y), o[2]); o[3] = fmaf(a, bfhi(v.y), o[3]);
    o[4] = fmaf(a, bflo(v.z), o[4]); o[5] = fmaf(a, bfhi(v.z), o[5]); o[6] = fmaf(a, bflo(v.w), o[6]); o[7] = fmaf(a, bfhi(v.w), o[7]);
}
__device__ __forceinline__ void fp8_dot16(const u32x4& w, const f32x2 (&h)[8], f32x2& acc0, f32x2& acc1) {
    const unsigned w0 = w.x, w1 = w.y, w2 = w.z, w3 = w.w;
    acc0 = __builtin_elementwise_fma(__builtin_amdgcn_cvt_pk_f32_fp8(w0, false), h[0], acc0); acc1 = __builtin_elementwise_fma(__builtin_amdgcn_cvt_pk_f32_fp8(w0, true), h[1], acc1);
    acc0 = __builtin_elementwise_fma(__builtin_amdgcn_cvt_pk_f32_fp8(w1, false), h[2], acc0); acc1 = __builtin_elementwise_fma(__builtin_amdgcn_cvt_pk_f32_fp8(w1, true), h[3], acc1);
    acc0 = __builtin_elementwise_fma(__builtin_amdgcn_cvt_pk_f32_fp8(w2, false), h[4], acc0); acc1 = __builtin_elementwise_fma(__builtin_amdgcn_cvt_pk_f32_fp8(w2, true), h[5], acc1);
    acc0 = __builtin_elementwise_fma(__builtin_amdgcn_cvt_pk_f32_fp8(w3, false), h[6], acc0); acc1 = __builtin_elementwise_fma(__builtin_amdgcn_cvt_pk_f32_fp8(w3, true), h[7], acc1);
}
__device__ __forceinline__ void fp8_axpy16(const u32x4& w, float a, f32x2 (&o)[8]) {
    const unsigned w0 = w.x, w1 = w.y, w2 = w.z, w3 = w.w; const f32x2 aa = {a, a};
    o[0] = __builtin_elementwise_fma(__builtin_amdgcn_cvt_pk_f32_fp8(w0, false), aa, o[0]); o[1] = __builtin_elementwise_fma(__builtin_amdgcn_cvt_pk_f32_fp8(w0, true), aa, o[1]);
    o[2] = __builtin_elementwise_fma(__builtin_amdgcn_cvt_pk_f32_fp8(w1, false), aa, o[2]); o[3] = __builtin_elementwise_fma(__builtin_amdgcn_cvt_pk_f32_fp8(w1, true), aa, o[3]);
    o[4] = __builtin_elementwise_fma(__builtin_amdgcn_cvt_pk_f32_fp8(w2, false), aa, o[4]); o[5] = __builtin_elementwise_fma(__builtin_amdgcn_cvt_pk_f32_fp8(w2, true), aa, o[5]);
    o[6] = __builtin_elementwise_fma(__builtin_amdgcn_cvt_pk_f32_fp8(w3, false), aa, o[6]); o[7] = __builtin_elementwise_fma(__builtin_amdgcn_cvt_pk_f32_fp8(w3, true), aa, o[7]);
}
template <int N>
__device__ __forceinline__ void group8_reduce(float* p, int lane) {
    { const bool up = (lane & 4) != 0;
#pragma unroll
      for (int i = 0; i < N / 2; ++i) { const float send = up ? p[i] : p[i + N / 2], keep = up ? p[i + N / 2] : p[i]; p[i] = keep + __shfl_xor(send, 4); } }
    { const bool up = (lane & 2) != 0;
#pragma unroll
      for (int i = 0; i < N / 4; ++i) { const float send = up ? p[i] : p[i + N / 4], keep = up ? p[i + N / 4] : p[i]; p[i] = keep + __shfl_xor(send, 2); } }
    { const bool up = (lane & 1) != 0;
#pragma unroll
      for (int i = 0; i < N / 8; ++i) { const float send = up ? p[i] : p[i + N / 8], keep = up ? p[i + N / 8] : p[i]; p[i] = keep + __shfl_xor(send, 1); } }
}
constexpr float H_SCALE = 16.0f;
__device__ __forceinline__ int q8(float v) { int q = (int)rintf(v * H_SCALE); return q < -127 ? -127 : (q > 127 ? 127 : q); }
__device__ __forceinline__ void p7a_upass(const Params& P, LAS unsigned char* lds, int wave, int lane) {
    unsigned char* ws = P.ws;
    const unsigned char* X1I = ws + WS_X1I8; const int* EI = (const int*)(ws + WS_K);
    const int x = blockIdx.x & 3, half = (blockIdx.x >> 2) & 1, rank = blockIdx.x >> 3, nloc = gridDim.x >> 3, p8 = lane >> 3, c = lane & 7;
    const unsigned char* Us = ws + WS_UT + (size_t)x * SLICE_BYTES + c * 16;
    float* AP = (float*)(ws + WS_SG) + (size_t)x * T * 128;
    const int ntok = (T / 2) / (nloc * NWAVES);
#define TOKU(n) (half * (T / 2) + (((n) * nloc + rank) * NWAVES) + wave)
#define U_META(Ev, Hv, t_) do { const u32x4* ep_ = (const u32x4*)(EI + (size_t)(t_) * 128 + 16 * p8); Ev[0] = ep_[0]; Ev[1] = ep_[1]; Ev[2] = ep_[2]; Ev[3] = ep_[3]; \
        const u32x4* hp_ = (const u32x4*)(X1I + (size_t)(t_) * D + 256 * x + 32 * c); Hv[0] = __builtin_nontemporal_load(hp_); Hv[1] = __builtin_nontemporal_load(hp_ + 1); } while (0)
#define U_ROW(e_) (*(const u32x4*)(Us + (size_t)(e_) * 128))
#define U_ISSUE(R, Ev, q0) do { R[0] = U_ROW(Ev[q0].x); R[1] = U_ROW(Ev[q0].y); R[2] = U_ROW(Ev[q0].z); R[3] = U_ROW(Ev[q0].w); R[4] = U_ROW(Ev[q0 + 1].x); R[5] = U_ROW(Ev[q0 + 1].y); R[6] = U_ROW(Ev[q0 + 1].z); R[7] = U_ROW(Ev[q0 + 1].w); } while (0)
    u32x4 eiA[4], eiB[4], hA[2], hB[2], bufP[8], bufQ[8];
    U_META(eiA, hA, TOKU(0));
    U_ISSUE(bufP, eiA, 0); U_ISSUE(bufQ, eiA, 2);
    U_META(eiB, hB, TOKU(ntok > 1 ? 1 : 0));
#pragma unroll 1
    for (int n = 0; n < ntok; ++n) {
        const int t = TOKU(n);
        const int he[4] = {(int)hA[0].x, (int)hA[0].z, (int)hA[1].x, (int)hA[1].z}, ho[4] = {(int)hA[0].y, (int)hA[0].w, (int)hA[1].y, (int)hA[1].w};
        int hs = 0;
#pragma unroll
        for (int w = 0; w < 4; ++w) { hs = __builtin_amdgcn_sdot4(he[w], 0x01010101, hs, false); hs = __builtin_amdgcn_sdot4(ho[w], 0x01010101, hs, false); }
        const float corr = -7.5f * (float)hs;
        float p[16];
#define U_DOT(Rv, dst) do { int acc_ = 0; const unsigned w0_ = Rv.x, w1_ = Rv.y, w2_ = Rv.z, w3_ = Rv.w; \
            acc_ = __builtin_amdgcn_sdot4((int)(w0_ & 0x0F0F0F0Fu), he[0], acc_, false); acc_ = __builtin_amdgcn_sdot4((int)((w0_ >> 4) & 0x0F0F0F0Fu), ho[0], acc_, false); \
            acc_ = __builtin_amdgcn_sdot4((int)(w1_ & 0x0F0F0F0Fu), he[1], acc_, false); acc_ = __builtin_amdgcn_sdot4((int)((w1_ >> 4) & 0x0F0F0F0Fu), ho[1], acc_, false); \
            acc_ = __builtin_amdgcn_sdot4((int)(w2_ & 0x0F0F0F0Fu), he[2], acc_, false); acc_ = __builtin_amdgcn_sdot4((int)((w2_ >> 4) & 0x0F0F0F0Fu), ho[2], acc_, false); \
            acc_ = __builtin_amdgcn_sdot4((int)(w3_ & 0x0F0F0F0Fu), he[3], acc_, false); acc_ = __builtin_amdgcn_sdot4((int)((w3_ >> 4) & 0x0F0F0F0Fu), ho[3], acc_, false); \
            dst = (float)acc_ + corr; } while (0)
#pragma unroll
        for (int i = 0; i < 8; ++i) U_DOT(bufP[i], p[i]);
        if (n + 1 < ntok) U_ISSUE(bufP, eiB, 0);
#pragma unroll
        for (int i = 0; i < 8; ++i) U_DOT(bufQ[i], p[8 + i]);
        if (n + 1 < ntok) U_ISSUE(bufQ, eiB, 2);
        group8_reduce<16>(p, lane);
        *(f32x2*)(AP + (size_t)t * 128 + 2 * lane) = (f32x2){p[0], p[1]};
#pragma unroll
        for (int i = 0; i < 4; ++i) eiA[i] = eiB[i];
        hA[0] = hB[0]; hA[1] = hB[1];
        if (n + 2 < ntok) U_META(eiB, hB, TOKU(n + 2));
    }
#undef TOKU
#undef U_META
#undef U_ROW
#undef U_ISSUE
#undef U_DOT
}
typedef int v2i_t __attribute__((ext_vector_type(2)));
typedef int v8i_t __attribute__((ext_vector_type(8)));
__device__ __forceinline__ void p7c_vpass_mfma(const Params& P, LAS unsigned char* lds, int wave, int lane) {
    unsigned char* ws = P.ws;
    const int* EI = (const int*)(ws + WS_K); const float* AP = (const float*)(ws + WS_SG); const float* EG = (const float*)(ws + WS_V); const float* ES = (const float*)(ws + WS_K + 16 * MiB);
    const float* RSTD2 = (const float*)(ws + WS_RSTD1 + 512 * 1024);
    LAS unsigned char* img = lds + wave * 16384;
    LAS unsigned char* actl = lds + LDS_MISC + wave * 512;
    LAS float* outl = (LAS float*)(lds + LDS_MISC + 4096 + wave * 1024);
    float* SS3 = (float*)(ws + WS_UY + 16 * MiB);
    const int x = blockIdx.x & 3, half = (blockIdx.x >> 2) & 1, rank = blockIdx.x >> 3, nloc = gridDim.x >> 3, p8 = lane >> 3, c = lane & 7, kq = lane >> 4, j16 = lane & 15;
    const unsigned char* Vs = ws + WS_VT + (size_t)x * SLICE_BYTES;
    bf16* X1B = (bf16*)(ws + WS_Q);
    const int ntok = (T / 2) / (nloc * NWAVES);
    const bool swp = (__builtin_amdgcn_cvt_scalef32_pk_fp4_f32(0u, 0.5f, 1.0f, 1.0f, 0) & 0xffu) != 0x21u;
    const unsigned coffe = (unsigned)((c ^ (p8 >> 1)) << 4), coffo = (unsigned)((c ^ (4 + (p8 >> 1))) << 4);
    LAS unsigned char* trb = img + (32 * kq + j16) * 128; const int f0 = (j16 >> 1) & 7;
#define TOK(n) (half * (T / 2) + (((n) * nloc + rank) * NWAVES) + wave)
#define V_META(EIv, t_) do { const u32x4* ep_ = (const u32x4*)(EI + (size_t)(t_) * 128 + 16 * p8); EIv[0] = __builtin_nontemporal_load(ep_); EIv[1] = __builtin_nontemporal_load(ep_ + 1); EIv[2] = __builtin_nontemporal_load(ep_ + 2); EIv[3] = __builtin_nontemporal_load(ep_ + 3); } while (0)
#define V_RAW(R, t_) do { const size_t o_ = (size_t)(t_) * 128 + 2 * lane; R[0] = __builtin_nontemporal_load((const f32x2*)(AP + o_)); R[1] = __builtin_nontemporal_load((const f32x2*)(AP + (size_t)T * 128 + o_)); R[2] = __builtin_nontemporal_load((const f32x2*)(AP + (size_t)2 * T * 128 + o_)); \
        R[3] = __builtin_nontemporal_load((const f32x2*)(AP + (size_t)3 * T * 128 + o_)); R[4] = __builtin_nontemporal_load((const f32x2*)(ES + o_)); R[5] = __builtin_nontemporal_load((const f32x2*)(EG + o_)); R[6] = (f32x2){RSTD2[t_], 0.f}; } while (0)
#define V_DMA(EIv) do { _Pragma("unroll") for (int q = 0; q < 16; ++q) { const unsigned e_ = (q & 3) == 0 ? EIv[q >> 2].x : (q & 3) == 1 ? EIv[q >> 2].y : (q & 3) == 2 ? EIv[q >> 2].z : EIv[q >> 2].w; \
        __builtin_amdgcn_global_load_lds((const unsigned*)(Vs + (size_t)e_ * 128 + ((q & 1) ? coffo : coffe)), (LAS unsigned*)(img + q * 1024), 16, 0, 0); } } while (0)
#define V_ACTA(Aop, Ainv, R) do { const f32x2 a_ = (R[0] + R[1]) + (R[2] + R[3]); const float asc_ = R[6].x * (1.0f / H_SCALE); \
        f32x2 act_ = {gelu_exact(a_.x * R[4].x * asc_) * R[5].x, gelu_exact(a_.y * R[4].y * asc_) * R[5].y}; \
        const float amax_ = wave_max(fmaxf(fabsf(act_.x), fabsf(act_.y))); const int ex_ = 7 - __builtin_amdgcn_frexp_expf(fmaxf(amax_, 1e-30f)); \
        const float sc_ = __builtin_amdgcn_ldexpf(1.0f, ex_); Ainv = __builtin_amdgcn_ldexpf(1.0f, -ex_); act_ *= sc_; \
        LDS_WAIT(); *(LAS f32x2*)(actl + lane * 8) = act_; LDS_WAIT(); \
        f32x4 va_[8]; _Pragma("unroll") for (int a = 0; a < 8; ++a) { const f32x2 lo2_ = *(const LAS f32x2*)(actl + (16 * a + 2 * kq) * 4), hi2_ = *(const LAS f32x2*)(actl + (16 * a + 8 + 2 * kq) * 4); va_[a] = (f32x4){lo2_.x, lo2_.y, hi2_.x, hi2_.y}; } \
        LDS_WAIT(); \
          \
        _Pragma("unroll") for (int w = 0; w < 8; ++w) { const int b_ = 2 * (w >> 2) + ((w >> 1) & 1), a0_ = 4 * (w & 1); \
            const float v0_ = va_[a0_][b_], v1_ = va_[a0_ + 1][b_], v2_ = va_[a0_ + 2][b_], v3_ = va_[a0_ + 3][b_]; \
            unsigned hi_ = __builtin_amdgcn_cvt_pk_fp8_f32(v0_, v1_, 0u, false); hi_ = __builtin_amdgcn_cvt_pk_fp8_f32(v2_, v3_, hi_, true); \
            const f32x2 d0_ = __builtin_amdgcn_cvt_pk_f32_fp8(hi_, false), d1_ = __builtin_amdgcn_cvt_pk_f32_fp8(hi_, true); \
            unsigned lo_ = __builtin_amdgcn_cvt_pk_fp8_f32(v0_ - d0_.x, v1_ - d0_.y, 0u, false); lo_ = __builtin_amdgcn_cvt_pk_fp8_f32(v2_ - d1_.x, v3_ - d1_.y, lo_, true); \
            Aop[w] = (int)(j16 == 0 ? hi_ : (j16 == 1 ? lo_ : 0u)); } } while (0)
    u32x4 eiA[4], eiB[4]; f32x2 rawC[7]; v8i_t aA, aB; float invA, invB;
    V_META(eiA, TOK(0)); V_RAW(rawC, TOK(0));
    V_DMA(eiA);
    V_META(eiB, TOK(ntok > 1 ? 1 : 0));
    V_ACTA(aA, invA, rawC); V_RAW(rawC, TOK(ntok > 1 ? 1 : 0));
    V_ACTA(aB, invB, rawC); V_RAW(rawC, TOK(ntok > 2 ? 2 : 0));
#pragma unroll 1
    for (int n = 0; n < ntok; ++n) {
        const int t = TOK(n);
        bf16* xr = X1B + (size_t)t * D + 256 * x + 4 * lane;
        const u32x2 x1w = __builtin_nontemporal_load((const u32x2*)xr);
        asm volatile("s_waitcnt vmcnt(0)" ::: "memory");
        f32x4 acc[16];
#pragma unroll
        for (int nb = 0; nb < 16; ++nb) {
            const int off = (((nb >> 1) ^ f0) << 4) | ((nb & 1) << 3);
            const v2i_t t0 = __builtin_amdgcn_ds_read_tr4_b64_v2i32((LAS v2i_t*)(trb + off)), t1 = __builtin_amdgcn_ds_read_tr4_b64_v2i32((LAS v2i_t*)(trb + 2048 + off));
            const v8i_t bop = {t0.x, t0.y, t1.x, t1.y, 0, 0, 0, 0};
            acc[nb] = __builtin_amdgcn_mfma_scale_f32_16x16x128_f8f6f4(aA, bop, (f32x4){0.f, 0.f, 0.f, 0.f}, 0, 4, 0, 0x7f7f7f7f, 0, 0x7f7f7f7f);
        }
        LDS_WAIT();
        asm volatile("" ::: "memory");
        if (n + 1 < ntok) V_DMA(eiB);
        if (lane < 16) {
#pragma unroll
            for (int nb = 0; nb < 16; ++nb) outl[16 * nb + lane] = acc[nb][0] + acc[nb][1]; }
        LDS_WAIT();
        f32x4 v = *(const LAS f32x4*)(outl + 4 * lane);
        LDS_WAIT();
        if (swp) v = (f32x4){v[1], v[0], v[3], v[2]};
        const float y0 = bflo(x1w.x) + v[0] * invA, y1 = bfhi(x1w.x) + v[1] * invA, y2 = bflo(x1w.y) + v[2] * invA, y3 = bfhi(x1w.y) + v[3] * invA;
        u32x2 ow; ow.x = cvtpk(y0, y1); ow.y = cvtpk(y2, y3);
        *(u32x2*)xr = ow;
        const float ss = wave_sum((y0 * y0 + y1 * y1) + (y2 * y2 + y3 * y3));
        if (lane == 0) SS3[(size_t)t * 4 + x] = ss;
        aA = aB; invA = invB;
        if (n + 2 < ntok) V_META(eiB, TOK(n + 2));
        V_ACTA(aB, invB, rawC);
        if (n + 3 < ntok) V_RAW(rawC, TOK(n + 3));
    }
#undef V_META
#undef V_RAW
#undef V_DMA
#undef V_ACTA
#undef TOK
}
__device__ __forceinline__ void p7d_norm(const Params& P) {
    unsigned char* ws = P.ws;
    const float* SS3 = (const float*)(ws + WS_UY + 16 * MiB); const bf16* X2B = (const bf16*)(ws + WS_Q);
    for (size_t i = (size_t)blockIdx.x * NTHR + threadIdx.x; i < (size_t)T * 128; i += (size_t)gridDim.x * NTHR) {
        const size_t t = i >> 7; const int q = (int)(i & 127);
        const f32x4 sa = *(const f32x4*)(SS3 + t * 4);
        const float r = rsqrtf(((sa[0] + sa[1]) + (sa[2] + sa[3])) * (1.0f / D) + EPS);
        const u32x4 w = __builtin_nontemporal_load((const u32x4*)(X2B + i * 8));
        const f32x4 g0 = *(const f32x4*)(P.g_fin + q * 8), g1 = *(const f32x4*)(P.g_fin + q * 8 + 4);
        f32x4* op = (f32x4*)(P.out + i * 8);
        __builtin_nontemporal_store((f32x4){bflo(w.x) * r * g0[0], bfhi(w.x) * r * g0[1], bflo(w.y) * r * g0[2], bfhi(w.y) * r * g0[3]}, op);
        __builtin_nontemporal_store((f32x4){bflo(w.z) * r * g1[0], bfhi(w.z) * r * g1[1], bflo(w.w) * r * g1[2], bfhi(w.w) * r * g1[3]}, op + 1);
    }
}

__global__ void __launch_bounds__(NTHR, 2) fwd_mega(Params P) {
    extern __shared__ __attribute__((aligned(16))) unsigned char lds_raw[];
    LAS unsigned char* lds = (LAS unsigned char*)lds_raw;
    const int tid = threadIdx.x, lane = tid & 63, wave = __builtin_amdgcn_readfirstlane(tid >> 6);
    unsigned char* ws = P.ws;
    const int G = gridDim.x, c = blockIdx.x;
    volatile LAS unsigned* bst = (volatile LAS unsigned*)(lds + LDS_MISC + 16000);
    if (tid < 4) bst[tid] = 0u;
    __syncthreads();
    XcdBarrier bar = xcd_barrier_post((unsigned*)(ws + WS_CTL), bst);

#ifndef PH_MASK
#define PH_MASK 0x7FF
#endif
#define IN(k) ((((PH_MASK) >> (k)) & 1) && P.lo <= (k) && (k) < P.hi)
#define SEAM(k) do { if (IN(k) && IN((k) + 1)) xcd_barrier(bar); } while (0)
#ifndef REP0
#define REP0 1
#endif
#ifndef REP1
#define REP1 1
#endif
#ifndef REP2
#define REP2 1
#endif
#ifndef REP3
#define REP3 1
#endif
#ifndef REP4
#define REP4 1
#endif
#ifndef REP5
#define REP5 1
#endif
#ifndef REP6
#define REP6 1
#endif
    if (IN(0)) for (int rep = 0; rep < REP0; ++rep) p0_prologue(P, lds, wave, lane);
    SEAM(0);
    if (IN(1)) for (int rep = 0; rep < REP1; ++rep) {
        pg8::Gemm g{(const pg8::bf16_t*)P.out, (const pg8::bf16_t*)(ws + WS_WIN), T, INW, D};
        pg8::StaticOrder S; S.init(T, INW, G, c);
        pg8::EpiProj E{(pg8::bf16_t*)(ws + WS_UY), (pg8::bf16_t*)(ws + WS_GV), (pg8::bf16_t*)(ws + WS_Q), (pg8::bf16_t*)(ws + WS_K), (pg8::bf16_t*)(ws + WS_V), (pg8::bf16_t*)(ws + WS_SG),
                       (const float*)(ws + WS_RSTD1), (float*)(ws + WS_SS)};
        pg8::gemm_phase<pg8::EpiProj, pg8::StaticOrder, true, true>(lds, g, S, E);
    }
    SEAM(1);
    if (IN(2)) { p2_sgu_mfma(P, lds, wave, lane);
    __syncthreads();
    for (int rep = 0; rep < REP2; ++rep) p2_attn_mfma(P, lds, wave, lane); }
    SEAM(2);
    if (IN(3)) for (int rep = 0; rep < REP3; ++rep) {
        pg8::StaticOrder S; S.init(T, 1024, G, c);
        pg8::Gemm g{(const pg8::bf16_t*)(ws + WS_UY), (const pg8::bf16_t*)(ws + WS_WA), T, 1024, 1536};
        pg8::EpiMergeFused E{(const pg8::bf16_t*)(ws + WS_SG), (pg8::bf16_t*)(ws + WS_GV)};
        pg8::gemm_phase<pg8::EpiMergeFused, pg8::StaticOrder, true, true>(lds, g, S, E);
    }
    SEAM(3);
    if (IN(4)) for (int rep = 0; rep < REP4; ++rep) {
        pg8::StaticOrder S; S.init(T, 1024, G, c);
        pg8::Gemm g{(const pg8::bf16_t*)(ws + WS_GV), (const pg8::bf16_t*)(ws + WS_WO), T, 1024, 1024};
        pg8::EpiX1 E{P.x, (pg8::bf16_t*)(ws + WS_Q), (float*)(ws + WS_SS2), ws + WS_X1I8};
        pg8::gemm_phase<pg8::EpiX1, pg8::StaticOrder, true, true>(lds, g, S, E);
    }
    SEAM(4);
    if (IN(5)) for (int rep = 0; rep < REP5; ++rep) {
        pg8::StaticOrder S; S.init(T, 2048, G, c);
        pg8::Gemm g{(const pg8::bf16_t*)(ws + WS_Q), (const pg8::bf16_t*)(ws + WS_WQ), T, 2048, 1024};
        pg8::EpiBlk E{(pg8::bf16_t*)(ws + WS_SG), 2048};
        pg8::gemm_phase<pg8::EpiBlk, pg8::StaticOrder, true, true>(lds, g, S, E);
    }
    SEAM(5);
    if (IN(6)) for (int rep = 0; rep < REP6; ++rep) p6_topk_mfma<0>(P, lds, wave, lane);
    SEAM(6);
#ifndef REP7A
#define REP7A 1
#endif
    if (IN(7)) for (int rep = 0; rep < REP7A; ++rep) p7a_upass(P, lds, wave, lane);
    if (IN(7) && IN(9)) xcd_barrier(bar);
    if (IN(9)) p7c_vpass_mfma(P, lds, wave, lane);
    SEAM(9);
    if (IN(10)) p7d_norm(P);
}

extern "C" void kernel_launch(void* const* d_in, const int* in_sizes, int n_in, void* d_out, int out_size, void* d_ws, size_t ws_size, hipStream_t stream) {
    static int grid = 0;
    if (grid == 0) {
        if (n_in != 15 || out_size != T * D || ws_size < WS_END) { fprintf(stderr, "kernel_launch: unexpected shapes/workspace (n_in %d out %d ws %zu)\n", n_in, out_size, ws_size); grid = -1; return; }
        int dev = 0, cus = 0, per_cu = 0;
        hipGetDevice(&dev); hipDeviceGetAttribute(&cus, hipDeviceAttributeMultiprocessorCount, dev);
        hipFuncSetAttribute((const void*)fwd_mega, hipFuncAttributeMaxDynamicSharedMemorySize, LDS_BYTES);
        hipOccupancyMaxActiveBlocksPerMultiprocessor(&per_cu, (const void*)fwd_mega, NTHR, LDS_BYTES);
        if (per_cu < 1) { fprintf(stderr, "kernel_launch: occupancy query says %d blocks per CU\n", per_cu); grid = -1; return; }
        grid = cus;
    }
    if (grid < 0) return;
    Params p{};
    p.x = (const float*)d_in[0]; p.g_mix = (const float*)d_in[1]; p.w_in = (const float*)d_in[2]; p.g_sgu = (const float*)d_in[3]; p.sgu_w = (const float*)d_in[4];
    p.sgu_b = (const float*)d_in[5]; p.w_a = (const float*)d_in[6]; p.w_b = (const float*)d_in[7]; p.w_out = (const float*)d_in[8]; p.g_ffn = (const float*)d_in[9];
    p.wq = (const float*)d_in[10]; p.subk = (const float*)d_in[11]; p.ut = (const float*)d_in[12]; p.vt = (const float*)d_in[13]; p.g_fin = (const float*)d_in[14];
    p.out = (float*)d_out; p.ws = (unsigned char*)d_ws;
    (void)hipMemsetAsync((char*)d_ws + WS_CTL, 0, CTL_ZERO_BYTES, stream);
#ifndef MK_SPLIT
    p.lo = 0; p.hi = 11;
    void* args[] = {&p};
    hipError_t e = hipLaunchCooperativeKernel((const void*)fwd_mega, dim3(grid), dim3(NTHR), args, LDS_BYTES, stream);
    if (e != hipSuccess) fprintf(stderr, "kernel_launch: cooperative launch failed: %s (grid %d)\n", hipGetErrorString(e), grid);
#else
    #ifndef PHASE_SEQ
#define PHASE_SEQ {0, 1, 2, 3, 4, 5, 6, 7, 8, 9, 10}
#endif
    { const int seq[] = PHASE_SEQ; for (int k : seq) { p.lo = k; p.hi = k + 1; hipLaunchKernelGGL(fwd_mega, dim3(grid), dim3(NTHR), LDS_BYTES, stream, p); } }
#endif
}
```

```cpp
#include <hip/hip_runtime.h>
#include <cstdio>
#include <cstdint>
#include <cstddef>
namespace pg8 {
#define PG8_LAS __attribute__((address_space(3)))
typedef unsigned short bf16_t;
typedef short bf16x8 __attribute__((ext_vector_type(8)));
typedef float f32x4 __attribute__((ext_vector_type(4)));
typedef unsigned u32x4 __attribute__((ext_vector_type(4)));
constexpr int BM = 256, BK = 64, HALF = 128, HTB = HALF * BK * 2  , STAGE_BYTES = 8 * HTB, NXCD = 8, WGM = 8;

__host__ __device__ __forceinline__ int lds_byte(int r, int c) { const int st = (r >> 4) * 2 + (c >> 5), rr = r & 15, cc = c & 31, ob = rr * 64 + cc * 2; return st * 1024 + (ob ^ (((ob >> 9) & 1) << 5)); }
__host__ __device__ __forceinline__ void stage_rc(int b, int& R, int& C) { const int st = b / 1024, sb = b % 1024, swz = sb ^ (((sb >> 9) & 1) << 5); R = (st >> 1) * 16 + swz / 64; C = (st & 1) * 32 + (swz % 64) / 2; }
__host__ __device__ __forceinline__ int perm32(int rho) { const int n = rho >> 4, i = rho & 15; return 8 * (i >> 2) + 4 * n + (i & 3); }

struct Unit { int pm, pn; };
struct Gemm { const bf16_t* A; const bf16_t* Bt; int M, N, K; };

struct StaticOrder {
    int nM, nN, nwg, G, c;
    __host__ __device__ void init(int M, int N, int G_, int c_) { nM = M / BM; nN = N / BM; nwg = nM * nN; G = G_; c = c_; }
    __host__ __device__ bool next(int i, Unit& u) const {
        const long L = (long)i * G + c; if (L >= nwg) return false;
        int wgid = (int)L; { const int q = nwg / NXCD, r = nwg % NXCD, xcd = wgid % NXCD, off = wgid / NXCD; wgid = (xcd < r ? xcd * (q + 1) : r * (q + 1) + (xcd - r) * q) + off; }
        const int nig = WGM * nN, gid = wgid / nig, fm = gid * WGM, gsz = (nM - fm) < WGM ? (nM - fm) : WGM;
        u.pm = fm + ((wgid % nig) % gsz); u.pn = (wgid % nig) / gsz; return true;
    }
    __device__ __forceinline__ void a_ready(const Unit&) const {}
    __device__ __forceinline__ void done(const Unit&) const {}
};

__device__ __forceinline__ unsigned cvt_pk_bf16(float lo, float hi) { unsigned r; asm volatile("v_cvt_pk_bf16_f32 %0, %1, %2" : "=v"(r) : "v"(lo), "v"(hi)); return r; }
typedef float f32x2 __attribute__((ext_vector_type(2)));
__device__ __forceinline__ f32x2 gelu_pk(f32x2 v) {
    const f32x2 av = __builtin_elementwise_abs(v), d = av * 0.2316418882f + 1.0f;
    f32x2 t; t.x = __builtin_amdgcn_rcpf(d.x); t.y = __builtin_amdgcn_rcpf(d.y);
    f32x2 q = t * 0.5307027145f + (-0.7265760135f); q = q * t + 0.7107068705f; q = q * t + (-0.142248368f); q = q * t + 0.127414796f; q = q * t;
    const f32x2 s = (v * v) * (-0.72134752044f);
    f32x2 e; e.x = __builtin_amdgcn_exp2f(s.x); e.y = __builtin_amdgcn_exp2f(s.y);
    const f32x2 m = v * (q * e), r = v - m;
    f32x2 o; o.x = v.x < 0.f ? m.x : r.x; o.y = v.y < 0.f ? m.y : r.y; return o;
}
__device__ __forceinline__ float sigm(float v) { return __builtin_amdgcn_rcpf(1.0f + __builtin_amdgcn_exp2f(v * -1.4426950408889634f)); }
__device__ __forceinline__ u32x4 pack8(const f32x4& a, const f32x4& b) { u32x4 w; w.x = cvt_pk_bf16(a[0], a[1]); w.y = cvt_pk_bf16(a[2], a[3]); w.z = cvt_pk_bf16(b[0], b[1]); w.w = cvt_pk_bf16(b[2], b[3]); return w; }
__device__ __forceinline__ float bf_lo(unsigned w) { return __uint_as_float(w << 16); }
__device__ __forceinline__ float bf_hi(unsigned w) { return __uint_as_float(w & 0xffff0000u); }

struct EpiProj {
    static constexpr bool PERM = true, AFTER_DRAIN = false; static constexpr int MID_T = -1;
    bf16_t *U, *GV, *Q, *Kb, *Vb, *SG; const float* rstd1; float* SS;
    __device__ __forceinline__ void operator()(const f32x4 (&acc)[2][2][4][2], const Unit& u, int wr, int wc, int fr, int fq) const {
        const int pn = u.pn; bf16_t* base; int ldc, colt, act = 0;
        if (pn < 4) { base = U; ldc = 1536; colt = pn * 256; act = 1; }
        else if (pn < 8) { base = GV; ldc = 1024; colt = (pn - 4) * 256; act = 1; }
        else if (pn < 14) { base = Q; ldc = 1536; colt = (pn - 8) * 256; }
        else if (pn < 16) { base = Kb; ldc = 512; colt = (pn - 14) * 256; }
        else if (pn < 18) { base = Vb; ldc = 512; colt = (pn - 16) * 256; }
        else { base = SG; ldc = 2048; colt = (pn - 18) * 256; act = 2; }
        const bool want_ss = (pn >= 4 && pn < 8);
        const int row0 = u.pm * BM + wr * 64 + fr, col0 = colt + wc * 32 + 8 * fq;
        float rsv[2][4];
#pragma unroll
        for (int ai = 0; ai < 2; ++ai)
#pragma unroll
            for (int m = 0; m < 4; ++m) rsv[ai][m] = rstd1[row0 + ai * HALF + m * 16];
#pragma unroll
        for (int ai = 0; ai < 2; ++ai)
#pragma unroll
            for (int m = 0; m < 4; ++m) {
                const int row = row0 + ai * HALF + m * 16; const float rs = rsv[ai][m];
                bf16_t* rowp = base + (size_t)row * ldc + col0; float ssq = 0.f;
#pragma unroll
                for (int bj = 0; bj < 2; ++bj) {
                    f32x4 v0 = acc[ai][bj][m][0] * rs, v1 = acc[ai][bj][m][1] * rs;
                    if (act == 1) { const f32x2 a = gelu_pk((f32x2){v0[0], v0[1]}), b = gelu_pk((f32x2){v0[2], v0[3]}), c = gelu_pk((f32x2){v1[0], v1[1]}), d = gelu_pk((f32x2){v1[2], v1[3]});
                        v0 = (f32x4){a.x, a.y, b.x, b.y}; v1 = (f32x4){c.x, c.y, d.x, d.y};
                        ssq += (v0[0] * v0[0] + v0[1] * v0[1]) + (v0[2] * v0[2] + v0[3] * v0[3]) + (v1[0] * v1[0] + v1[1] * v1[1]) + (v1[2] * v1[2] + v1[3] * v1[3]); }
                    else if (act == 2) {
#pragma unroll
                        for (int e = 0; e < 4; ++e) { v0[e] = sigm(v0[e]); v1[e] = sigm(v1[e]); }
                        *(u32x4*)(SG + ((size_t)(u.pm * 16 + ai * 8 + wr * 4 + m) * 64 + (pn - 18) * 8 + bj * 4 + wc) * 512 + (fq * 16 + fr) * 8) = pack8(v0, v1); }
                    if (want_ss) *(u32x4*)(GV + ((size_t)(u.pm * 16 + ai * 8 + wr * 4 + m) * 32 + (pn - 4) * 8 + bj * 4 + wc) * 512 + (fq * 16 + fr) * 8) = pack8(v0, v1);
                    else if (act != 2) *(u32x4*)(rowp + bj * HALF) = pack8(v0, v1);
                }
                if (want_ss) { ssq += __shfl_xor(ssq, 16); ssq += __shfl_xor(ssq, 32); if (fq == 0) SS[(size_t)row * 16 + (pn - 4) * 4 + wc] = ssq; }
            }
    }
};
struct EpiMergeA {
    static constexpr bool PERM = true, AFTER_DRAIN = false; static constexpr int MID_T = -1;
    const bf16_t* SG; float* MGF;
    __device__ __forceinline__ void operator()(const f32x4 (&acc)[2][2][4][2], const Unit& u, int wr, int wc, int fr, int fq) const {
        const int row0 = u.pm * BM + wr * 64 + fr, col0 = u.pn * BM + wc * 32 + 8 * fq;
#pragma unroll
        for (int ai = 0; ai < 2; ++ai)
#pragma unroll
            for (int m = 0; m < 4; ++m) { const int row = row0 + ai * HALF + m * 16;
#pragma unroll
                for (int bj = 0; bj < 2; ++bj) { const int col = col0 + bj * HALF;
                    const u32x4 s = *(const u32x4*)(SG + (size_t)row * 2048 + col);
                    f32x4 v0 = acc[ai][bj][m][0], v1 = acc[ai][bj][m][1];
                    v0[0] *= bf_lo(s.x); v0[1] *= bf_hi(s.x); v0[2] *= bf_lo(s.y); v0[3] *= bf_hi(s.y);
                    v1[0] *= bf_lo(s.z); v1[1] *= bf_hi(s.z); v1[2] *= bf_lo(s.w); v1[3] *= bf_hi(s.w);
                    float* o = MGF + (size_t)row * 1024 + col; *(f32x4*)o = v0; *(f32x4*)(o + 4) = v1; } }
    }
};
struct EpiMergeB {
    static constexpr bool PERM = true, AFTER_DRAIN = false; static constexpr int MID_T = -1;
    const bf16_t* SG; const float* MGF; bf16_t* MG;
    __device__ __forceinline__ void operator()(const f32x4 (&acc)[2][2][4][2], const Unit& u, int wr, int wc, int fr, int fq) const {
        const int row0 = u.pm * BM + wr * 64 + fr, col0 = u.pn * BM + wc * 32 + 8 * fq;
#pragma unroll
        for (int ai = 0; ai < 2; ++ai)
#pragma unroll
            for (int m = 0; m < 4; ++m) { const int row = row0 + ai * HALF + m * 16;
#pragma unroll
                for (int bj = 0; bj < 2; ++bj) { const int col = col0 + bj * HALF;
                    const u32x4 s = *(const u32x4*)(SG + (size_t)row * 2048 + 1024 + col);
                    const float* mi = MGF + (size_t)row * 1024 + col; f32x4 v0 = *(const f32x4*)mi, v1 = *(const f32x4*)(mi + 4);
                    const f32x4 a0 = acc[ai][bj][m][0], a1 = acc[ai][bj][m][1];
                    v0[0] += a0[0] * bf_lo(s.x); v0[1] += a0[1] * bf_hi(s.x); v0[2] += a0[2] * bf_lo(s.y); v0[3] += a0[3] * bf_hi(s.y);
                    v1[0] += a1[0] * bf_lo(s.z); v1[1] += a1[1] * bf_hi(s.z); v1[2] += a1[2] * bf_lo(s.w); v1[3] += a1[3] * bf_hi(s.w);
                    *(u32x4*)(MG + (size_t)row * 1024 + col) = pack8(v0, v1); } }
    }
};
struct EpiX1 {
    static constexpr bool PERM = true, AFTER_DRAIN = false; static constexpr int MID_T = -1;
    const bf16_t* XB; bf16_t* X1B; float* SS2; unsigned char* X1I8;
    __device__ __forceinline__ void operator()(const f32x4 (&acc)[2][2][4][2], const Unit& u, int wr, int wc, int fr, int fq) const {
        const int row0 = u.pm * BM + wr * 64 + fr, col0 = u.pn * BM + wc * 32 + 8 * fq;
#pragma unroll
        for (int ai = 0; ai < 2; ++ai)
#pragma unroll
            for (int m = 0; m < 4; ++m) { const int row = row0 + ai * HALF + m * 16; float ssq = 0.f;
#pragma unroll
                for (int bj = 0; bj < 2; ++bj) { const int col = col0 + bj * HALF;
                    const u32x4 xw = __builtin_nontemporal_load((const u32x4*)(XB + (size_t)row * 1024 + col));
                    const f32x4 v0 = (f32x4){bf_lo(xw.x), bf_hi(xw.x), bf_lo(xw.y), bf_hi(xw.y)} + acc[ai][bj][m][0], v1 = (f32x4){bf_lo(xw.z), bf_hi(xw.z), bf_lo(xw.w), bf_hi(xw.w)} + acc[ai][bj][m][1];
                    ssq += (v0[0] * v0[0] + v0[1] * v0[1]) + (v0[2] * v0[2] + v0[3] * v0[3]) + (v1[0] * v1[0] + v1[1] * v1[1]) + (v1[2] * v1[2] + v1[3] * v1[3]);
                    *(u32x4*)(X1B + (size_t)row * 1024 + col) = pack8(v0, v1);
                    { int q[8];
#pragma unroll
                      for (int k = 0; k < 4; ++k) { int a = (int)__builtin_rintf(v0[k] * 16.0f), b = (int)__builtin_rintf(v1[k] * 16.0f); q[k] = a < -127 ? -127 : (a > 127 ? 127 : a); q[4 + k] = b < -127 ? -127 : (b > 127 ? 127 : b); }
                      unsigned we = (unsigned)(q[0] & 255) | ((unsigned)(q[2] & 255) << 8) | ((unsigned)(q[4] & 255) << 16) | ((unsigned)q[6] << 24);
                      unsigned wo = (unsigned)(q[1] & 255) | ((unsigned)(q[3] & 255) << 8) | ((unsigned)(q[5] & 255) << 16) | ((unsigned)q[7] << 24);
                      unsigned* ip = (unsigned*)(X1I8 + (size_t)row * 1024 + col); ip[0] = we; ip[1] = wo; } }
                ssq += __shfl_xor(ssq, 16); ssq += __shfl_xor(ssq, 32); if (fq == 0) SS2[(size_t)row * 16 + u.pn * 4 + wc] = ssq; }
    }
};
struct EpiBlk {
    static constexpr bool PERM = true, AFTER_DRAIN = false; static constexpr int MID_T = -1;
    bf16_t* O; int ldc;
    __device__ __forceinline__ void operator()(const f32x4 (&acc)[2][2][4][2], const Unit& u, int wr, int wc, int fr, int fq) const {
        const int rb0 = u.pm * 16 + wr * 4, cb0 = u.pn * 8 + wc, nb = ldc >> 5;
        bf16_t* base = O + (size_t)(fq * 16 + fr) * 8;
#pragma unroll
        for (int ai = 0; ai < 2; ++ai)
#pragma unroll
            for (int m = 0; m < 4; ++m)
#pragma unroll
                for (int bj = 0; bj < 2; ++bj) *(u32x4*)(base + ((size_t)(rb0 + ai * 8 + m) * nb + cb0 + bj * 4) * 512) = pack8(acc[ai][bj][m][0], acc[ai][bj][m][1]);
    }
};
struct EpiPlain {
    static constexpr bool PERM = true, AFTER_DRAIN = false; static constexpr int MID_T = -1;
    bf16_t* O; int ldc;
    __device__ __forceinline__ void operator()(const f32x4 (&acc)[2][2][4][2], const Unit& u, int wr, int wc, int fr, int fq) const {
        const int row0 = u.pm * BM + wr * 64 + fr, col0 = u.pn * BM + wc * 32 + 8 * fq;
#pragma unroll
        for (int ai = 0; ai < 2; ++ai)
#pragma unroll
            for (int m = 0; m < 4; ++m) { const int row = row0 + ai * HALF + m * 16;
#pragma unroll
                for (int bj = 0; bj < 2; ++bj) *(u32x4*)(O + (size_t)row * ldc + col0 + bj * HALF) = pack8(acc[ai][bj][m][0], acc[ai][bj][m][1]); }
    }
};

struct EpiMergeFused {
    static constexpr bool PERM = true, AFTER_DRAIN = false; static constexpr int MID_T = 16;
    const bf16_t* SG; bf16_t* MG;
    __device__ __forceinline__ void mid(f32x4 (&acc)[2][2][4][2], const Unit& u, int wr, int wc, int fr, int fq) const {
        int row0 = u.pm * BM + wr * 64 + fr, col0 = u.pn * BM + wc * 32 + 8 * fq;
        asm volatile("" : "+v"(row0), "+v"(col0));
#pragma unroll
        for (int ai = 0; ai < 2; ++ai) {
            u32x4 ga[4][2], gb[4][2];
#pragma unroll
            for (int m = 0; m < 4; ++m)
#pragma unroll
                for (int bj = 0; bj < 2; ++bj) { const int row = row0 + ai * HALF + m * 16, col = col0 + bj * HALF;
                    const bf16_t* sp = SG + ((size_t)(row >> 4) * 64 + (col >> 5)) * 512 + (fq * 16 + fr) * 8;
                    ga[m][bj] = *(const u32x4*)sp; gb[m][bj] = *(const u32x4*)(sp + 32 * 512); }
#pragma unroll
            for (int m = 0; m < 4; ++m)
#pragma unroll
                for (int bj = 0; bj < 2; ++bj) { const u32x4 sa = ga[m][bj], sb = gb[m][bj];
                    f32x4& v0 = acc[ai][bj][m][0]; f32x4& v1 = acc[ai][bj][m][1];
                    v0[0] *= bf_lo(sa.x) * __builtin_amdgcn_rcpf(fmaxf(bf_lo(sb.x), 1e-30f)); v0[1] *= bf_hi(sa.x) * __builtin_amdgcn_rcpf(fmaxf(bf_hi(sb.x), 1e-30f));
                    v0[2] *= bf_lo(sa.y) * __builtin_amdgcn_rcpf(fmaxf(bf_lo(sb.y), 1e-30f)); v0[3] *= bf_hi(sa.y) * __builtin_amdgcn_rcpf(fmaxf(bf_hi(sb.y), 1e-30f));
                    v1[0] *= bf_lo(sa.z) * __builtin_amdgcn_rcpf(fmaxf(bf_lo(sb.z), 1e-30f)); v1[1] *= bf_hi(sa.z) * __builtin_amdgcn_rcpf(fmaxf(bf_hi(sb.z), 1e-30f));
                    v1[2] *= bf_lo(sa.w) * __builtin_amdgcn_rcpf(fmaxf(bf_lo(sb.w), 1e-30f)); v1[3] *= bf_hi(sa.w) * __builtin_amdgcn_rcpf(fmaxf(bf_hi(sb.w), 1e-30f)); }
            asm volatile("" ::: "memory"); }
    }
    __device__ __forceinline__ void operator()(const f32x4 (&acc)[2][2][4][2], const Unit& u, int wr, int wc, int fr, int fq) const {
        const int row0 = u.pm * BM + wr * 64 + fr, col0 = u.pn * BM + wc * 32 + 8 * fq;
#pragma unroll
        for (int ai = 0; ai < 2; ++ai) {
            u32x4 gs[4][2];
#pragma unroll
            for (int m = 0; m < 4; ++m)
#pragma unroll
                for (int bj = 0; bj < 2; ++bj) { const int row = row0 + ai * HALF + m * 16, col = col0 + bj * HALF;
                    gs[m][bj] = *(const u32x4*)(SG + ((size_t)(row >> 4) * 64 + 32 + (col >> 5)) * 512 + (fq * 16 + fr) * 8); }
#pragma unroll
            for (int m = 0; m < 4; ++m) { const int row = row0 + ai * HALF + m * 16;
#pragma unroll
                for (int bj = 0; bj < 2; ++bj) { const int col = col0 + bj * HALF;
                    const u32x4 s = gs[m][bj];
                    f32x4 v0 = acc[ai][bj][m][0], v1 = acc[ai][bj][m][1];
                    v0[0] *= bf_lo(s.x); v0[1] *= bf_hi(s.x); v0[2] *= bf_lo(s.y); v0[3] *= bf_hi(s.y);
                    v1[0] *= bf_lo(s.z); v1[1] *= bf_hi(s.z); v1[2] *= bf_lo(s.w); v1[3] *= bf_hi(s.w);
                    *(u32x4*)(MG + (size_t)row * 1024 + col) = pack8(v0, v1); } }
        }
    }
};
template <class Epi, class Sched, bool ALIGN_EPI = false, bool SP2 = false>
__device__ __forceinline__ void gemm_phase(PG8_LAS unsigned char* lds, const Gemm g, const Sched& S, const Epi& E) {
    const int tid = threadIdx.x, wid = __builtin_amdgcn_readfirstlane(tid >> 6), lane = tid & 63, wr = wid >> 2, wc = wid & 3, fr = lane & 15, fq = lane >> 4;
    const int K = g.K, nt = K / BK;
    unsigned voffA[2], voffB[2];
#pragma unroll
    for (int i = 0; i < 2; ++i) { int R, C; stage_rc(tid * 16 + i * 8192, R, C); const int Rb = Epi::PERM ? ((R & ~31) + perm32(R & 31)) : R;
        voffA[i] = (unsigned)(R * K + C) * 2u; voffB[i] = (unsigned)(Rb * K + C) * 2u; }
    const size_t kstep = (size_t)(BK * 2);
    const size_t hstep = (size_t)HALF * K * 2;
    const size_t tstep = 2 * hstep;
    const unsigned ldsw = (unsigned)wid * 1024u;
    const int aoff = lds_byte(wr * 64 + fr, fq * 8), boff = lds_byte(wc * 32 + fr, fq * 8);
#define PG8_SA(b, h) (((b) * 2 + (h)) * HTB)
#define PG8_SB(b, h) ((4 + (b) * 2 + (h)) * HTB)
#define PG8_STAGE(bufoff, gbase, voff) do { _Pragma("unroll") for (int _i = 0; _i < 2; ++_i) \
        __builtin_amdgcn_global_load_lds((const unsigned*)((const char*)(gbase) + (voff)[_i]), (PG8_LAS unsigned*)(lds + (bufoff) + ldsw + _i * 8192), 16, 0, 0); } while (0)
#define PG8_LDA(dst, b, h) do { _Pragma("unroll") for (int m = 0; m < 4; ++m) _Pragma("unroll") for (int k = 0; k < 2; ++k) dst[m][k] = *(const PG8_LAS bf16x8*)(lds + PG8_SA(b, h) + aoff + m * 2048 + k * 1024); } while (0)
#define PG8_LDB(dst, b, h) do { _Pragma("unroll") for (int n = 0; n < 2; ++n) _Pragma("unroll") for (int k = 0; k < 2; ++k) dst[n][k] = *(const PG8_LAS bf16x8*)(lds + PG8_SB(b, h) + boff + n * 2048 + k * 1024); } while (0)
#define PG8_MMA(ai, bj, At, Bt) do { __builtin_amdgcn_s_setprio(1); _Pragma("unroll") for (int m = 0; m < 4; ++m) _Pragma("unroll") for (int n = 0; n < 2; ++n) _Pragma("unroll") for (int k = 0; k < 2; ++k) \
        acc[ai][bj][m][n] = __builtin_amdgcn_mfma_f32_16x16x32_bf16(Bt[n][k], At[m][k], acc[ai][bj][m][n], 0, 0, 0); __builtin_amdgcn_s_setprio(0); } while (0)
#define PG8_WAIT_V(n) asm volatile("s_waitcnt vmcnt(" #n ")" ::: "memory")
#define PG8_WAIT_L(n) asm volatile("s_waitcnt lgkmcnt(" #n ")" ::: "memory")
#define PG8_BAR __builtin_amdgcn_s_barrier()
#define PG8_SCHED __builtin_amdgcn_sched_barrier(0)
    Unit cur, nxt; int ui = 0;
    if (!S.next(0, cur)) return;
    f32x4 acc[2][2][4][2];
#pragma unroll
    for (int a = 0; a < 2; ++a)
#pragma unroll
        for (int b = 0; b < 2; ++b)
#pragma unroll
            for (int m = 0; m < 4; ++m)
#pragma unroll
                for (int n = 0; n < 2; ++n) acc[a][b][m][n] = (f32x4){0.f, 0.f, 0.f, 0.f};
    bf16x8 At[4][2], B0[2][2], B1[2][2];
    const char* cA = (const char*)g.A + (size_t)cur.pm * tstep; const char* cB = (const char*)g.Bt + (size_t)cur.pn * tstep;
    S.a_ready(cur);
    if constexpr (SP2) {
        PG8_STAGE(PG8_SB(0, 0), cB, voffB); PG8_STAGE(PG8_SB(0, 1), cB + hstep, voffB); PG8_STAGE(PG8_SA(0, 0), cA, voffA); PG8_STAGE(PG8_SA(0, 1), cA + hstep, voffA);
        if (wr == 1) PG8_BAR;
        PG8_WAIT_V(2); PG8_BAR;
        PG8_STAGE(PG8_SB(1, 0), cB + kstep, voffB); PG8_STAGE(PG8_SA(1, 0), cA + kstep, voffA); PG8_STAGE(PG8_SB(1, 1), cB + hstep + kstep, voffB);
        PG8_WAIT_V(6); PG8_BAR;
    } else {
        PG8_STAGE(PG8_SB(0, 0), cB, voffB); PG8_STAGE(PG8_SA(0, 0), cA, voffA); PG8_STAGE(PG8_SB(0, 1), cB + hstep, voffB); PG8_STAGE(PG8_SA(0, 1), cA + hstep, voffA);
        if (wr == 1) PG8_BAR;
        PG8_WAIT_V(4); PG8_BAR;
        PG8_STAGE(PG8_SB(1, 0), cB + kstep, voffB); PG8_STAGE(PG8_SA(1, 0), cA + kstep, voffA); PG8_STAGE(PG8_SB(1, 1), cB + hstep + kstep, voffB);
        PG8_WAIT_V(6); PG8_BAR;
    }
    for (;;) {
        const bool has_next = S.next(ui + 1, nxt);
        const char* nA = has_next ? (const char*)g.A + (size_t)nxt.pm * tstep : cA; const char* nB = has_next ? (const char*)g.Bt + (size_t)nxt.pn * tstep : cB;
        for (int t = 0; t < nt; t += 2) {
            if constexpr (Epi::MID_T >= 0) { if (t == Epi::MID_T) E.mid(acc, cur, wr, wc, fr, fq); }
            const bool last = (t == nt - 2);
            const char* a1 = cA + (size_t)(t + 1) * kstep;
            const char* a2 = last ? nA : cA + (size_t)(t + 2) * kstep; const char* b2 = last ? nB : cB + (size_t)(t + 2) * kstep;
            const char* a3 = a2 + kstep; const char* b3 = b2 + kstep;
            if (last && has_next) S.a_ready(nxt);
            if constexpr (SP2) {
            PG8_LDB(B0, 0, 0); PG8_LDB(B1, 0, 1); PG8_SCHED; PG8_LDA(At, 0, 0); PG8_STAGE(PG8_SA(1, 1), a1 + hstep, voffA);
            PG8_WAIT_V(8); PG8_WAIT_L(0); PG8_BAR; PG8_MMA(0, 0, At, B0); PG8_MMA(0, 1, At, B1); PG8_BAR; PG8_SCHED;
            PG8_LDA(At, 0, 1); PG8_STAGE(PG8_SB(0, 0), b2, voffB); PG8_STAGE(PG8_SB(0, 1), b2 + hstep, voffB); PG8_STAGE(PG8_SA(0, 0), a2, voffA);
            PG8_WAIT_V(8); PG8_WAIT_L(0); PG8_BAR; PG8_MMA(1, 0, At, B0); PG8_MMA(1, 1, At, B1); PG8_BAR; PG8_SCHED;
            PG8_LDB(B0, 1, 0); PG8_LDB(B1, 1, 1); PG8_SCHED; PG8_LDA(At, 1, 0); PG8_STAGE(PG8_SA(0, 1), a2 + hstep, voffA);
            PG8_WAIT_V(8); PG8_WAIT_L(0); PG8_BAR; PG8_MMA(0, 0, At, B0); PG8_MMA(0, 1, At, B1); PG8_BAR; PG8_SCHED;
            PG8_LDA(At, 1, 1); PG8_STAGE(PG8_SB(1, 0), b3, voffB); PG8_STAGE(PG8_SB(1, 1), b3 + hstep, voffB); PG8_STAGE(PG8_SA(1, 0), a3, voffA);
            PG8_WAIT_V(8); PG8_WAIT_L(0); PG8_BAR; PG8_MMA(1, 0, At, B0); PG8_MMA(1, 1, At, B1); PG8_BAR; PG8_SCHED;
            } else {
            PG8_LDB(B0, 0, 0); PG8_SCHED; PG8_LDA(At, 0, 0); PG8_STAGE(PG8_SA(1, 1), a1 + hstep, voffA);
            PG8_WAIT_L(8); PG8_BAR; PG8_WAIT_L(0); PG8_MMA(0, 0, At, B0); PG8_BAR; PG8_SCHED;
            PG8_LDB(B1, 0, 1); PG8_STAGE(PG8_SB(0, 0), b2, voffB);
            PG8_BAR; PG8_WAIT_L(0); PG8_MMA(0, 1, At, B1); PG8_BAR;
            PG8_LDA(At, 0, 1); PG8_STAGE(PG8_SA(0, 0), a2, voffA);
            PG8_BAR; PG8_WAIT_L(0); PG8_MMA(1, 0, At, B0); PG8_BAR; PG8_SCHED;
            PG8_STAGE(PG8_SB(0, 1), b2 + hstep, voffB);
            PG8_WAIT_V(6); PG8_BAR; PG8_MMA(1, 1, At, B1); PG8_BAR;
            PG8_LDB(B0, 1, 0); PG8_SCHED; PG8_LDA(At, 1, 0); PG8_STAGE(PG8_SA(0, 1), a2 + hstep, voffA);
            PG8_WAIT_L(8); PG8_BAR; PG8_WAIT_L(0); PG8_MMA(0, 0, At, B0); PG8_BAR; PG8_SCHED;
            PG8_LDB(B1, 1, 1); PG8_STAGE(PG8_SB(1, 0), b3, voffB);
            PG8_BAR; PG8_WAIT_L(0); PG8_MMA(0, 1, At, B1); PG8_BAR;
            PG8_LDA(At, 1, 1); PG8_STAGE(PG8_SA(1, 0), a3, voffA);
            PG8_BAR; PG8_WAIT_L(0); PG8_MMA(1, 0, At, B0); PG8_BAR; PG8_SCHED;
            PG8_STAGE(PG8_SB(1, 1), b3 + hstep, voffB);
            PG8_WAIT_V(6); PG8_BAR; PG8_MMA(1, 1, At, B1); PG8_BAR;
            }
        }
        if constexpr (ALIGN_EPI) { if (wr == 0) PG8_BAR; }
        if constexpr (!Epi::AFTER_DRAIN) { E(acc, cur, wr, wc, fr, fq); S.done(cur); }
        if (!has_next) break;
#pragma unroll
        for (int a = 0; a < 2; ++a)
#pragma unroll
            for (int b = 0; b < 2; ++b)
#pragma unroll
                for (int m = 0; m < 4; ++m)
#pragma unroll
                    for (int n = 0; n < 2; ++n) acc[a][b][m][n] = (f32x4){0.f, 0.f, 0.f, 0.f};
        cur = nxt; cA = nA; cB = nB; ++ui;
        if constexpr (ALIGN_EPI) { if (wr == 1) PG8_BAR; }
    }
    PG8_WAIT_V(0);
    if constexpr (!ALIGN_EPI) { if (wr == 0) PG8_BAR; }
    PG8_BAR;
    if constexpr (Epi::AFTER_DRAIN) { E.fused(acc, cur, wr, wc, fr, fq, lds, wid, lane); S.done(cur); }
#undef PG8_SA
#undef PG8_SB
#undef PG8_STAGE
#undef PG8_LDA
#undef PG8_LDB
#undef PG8_MMA
#undef PG8_WAIT_V
#undef PG8_WAIT_L
#undef PG8_BAR
#undef PG8_SCHED
}
}
constexpr int D = 1024, BATCH = 4, SEQ = 8192, T = BATCH * SEQ, INW = 6656;
constexpr int NTHR = 512, NWAVES = 8;
constexpr float EPS = 1e-6f;
constexpr size_t MiB = 1u << 20;
constexpr size_t WS_CTL = 0, CTL_ZERO_BYTES = 16384;
constexpr size_t WS_RSTD1 = 1 * MiB, WS_SS = 2 * MiB, WS_SS2 = 4 * MiB, WS_LSE = 6 * MiB;
constexpr size_t WS_WIN = 9 * MiB;
constexpr size_t WS_WA = 22 * MiB, WS_WO = 25 * MiB, WS_WQ = 27 * MiB;
constexpr size_t WS_SUBK = 31 * MiB;
constexpr size_t WS_SGUW = 31 * MiB + 512 * 1024;
constexpr size_t WS_UT = 32 * MiB, WS_VT = 48 * MiB;
constexpr size_t WS_UY = 64 * MiB;
constexpr int UYP = 1536;
constexpr size_t WS_X1I8 = WS_UY + 32 * MiB;
constexpr size_t WS_GV = 160 * MiB;
constexpr size_t WS_Q = 224 * MiB;
constexpr size_t WS_K = 320 * MiB, WS_V = 352 * MiB;
constexpr size_t WS_SG = 384 * MiB;
constexpr size_t WS_END = 512 * MiB;
constexpr int LDS_BYTES = 147456;
constexpr int LDS_MISC = 131072;

#define LAS __attribute__((address_space(3)))
typedef unsigned short bf16;
typedef unsigned u32x4 __attribute__((ext_vector_type(4)));
typedef unsigned u32x2 __attribute__((ext_vector_type(2)));
typedef float f32x4 __attribute__((ext_vector_type(4)));
typedef float f32x2 __attribute__((ext_vector_type(2)));
typedef __bf16 bf16x2_t __attribute__((ext_vector_type(2)));
#define LDS_WAIT() asm volatile("s_waitcnt lgkmcnt(0)" ::: "memory")

__device__ __forceinline__ unsigned f2bf(float f) { unsigned u = __builtin_bit_cast(unsigned, f); return (u + 0x7fffu + ((u >> 16) & 1u)) >> 16; }
__device__ __forceinline__ unsigned pk2(float lo, float hi) { return f2bf(lo) | (f2bf(hi) << 16); }
__device__ __forceinline__ float bf2f(bf16 b) { return __uint_as_float((unsigned)b << 16); }
__device__ __forceinline__ float bflo(unsigned w) { return __uint_as_float(w << 16); }
__device__ __forceinline__ float bfhi(unsigned w) { return __uint_as_float(w & 0xffff0000u); }
#define WAVE_ROR(v, n) __uint_as_float(__builtin_amdgcn_update_dpp(0u, __float_as_uint(v), 0x120 + (n), 0xf, 0xf, false))
__device__ __forceinline__ float wave_sum(float v) {
    v += WAVE_ROR(v, 8); v += WAVE_ROR(v, 4); v += WAVE_ROR(v, 2); v += WAVE_ROR(v, 1);
    { const auto r = __builtin_amdgcn_permlane16_swap(__float_as_uint(v), __float_as_uint(v), false, false); v = __uint_as_float(r[0]) + __uint_as_float(r[1]); }
    { const auto r = __builtin_amdgcn_permlane32_swap(__float_as_uint(v), __float_as_uint(v), false, false); v = __uint_as_float(r[0]) + __uint_as_float(r[1]); }
    return v;
}
__device__ __forceinline__ float wave_max(float v) {
    v = fmaxf(v, WAVE_ROR(v, 8)); v = fmaxf(v, WAVE_ROR(v, 4)); v = fmaxf(v, WAVE_ROR(v, 2)); v = fmaxf(v, WAVE_ROR(v, 1));
    { const auto r = __builtin_amdgcn_permlane16_swap(__float_as_uint(v), __float_as_uint(v), false, false); v = fmaxf(__uint_as_float(r[0]), __uint_as_float(r[1])); }
    { const auto r = __builtin_amdgcn_permlane32_swap(__float_as_uint(v), __float_as_uint(v), false, false); v = fmaxf(__uint_as_float(r[0]), __uint_as_float(r[1])); }
    return v;
}
__device__ __forceinline__ float gelu_exact(float v) { return 0.5f * v * (1.0f + erff(v * 0.70710678118654752f)); }

#define XB_TMO      128
#define XB_XCNT(j)  (256  + 64 * (j))
#define XB_XSUB(j)  (1280 + 64 * (j))
#define XB_XGEN(j)  (2304 + 64 * (j))
#define XB_TOP      3328
#define XB_TOPGEN   3392
#define XCD_BAR_WORDS 3456
#define XB_SPIN_CAP (1u << 18)

__device__ __forceinline__ unsigned xb_ld(unsigned* p)              { return __hip_atomic_load(p, __ATOMIC_RELAXED, __HIP_MEMORY_SCOPE_AGENT); }
__device__ __forceinline__ unsigned xb_add(unsigned* p, unsigned v) { return __hip_atomic_fetch_add(p, v, __ATOMIC_RELAXED, __HIP_MEMORY_SCOPE_AGENT); }
__device__ __forceinline__ unsigned xb_xcc_id() { return (unsigned)__builtin_amdgcn_s_getreg((3 << 11) | 20) & 0xFu; }
#define XB_SPIN(cond, bar) do { unsigned _sp = 0; while (cond) { __builtin_amdgcn_s_sleep(1); \
    if ((++_sp & 255u) == 0u) { if (xb_ld(&(bar)[XB_TMO])) break; if (_sp > XB_SPIN_CAP) { atomicAdd(&(bar)[XB_TMO], 1u); break; } } } } while (0)

struct XcdBarrier {
    unsigned* bar; unsigned x;
    volatile LAS unsigned* st;
};

__device__ __forceinline__ XcdBarrier xcd_barrier_post(unsigned* bar, volatile LAS unsigned* st) {
    XcdBarrier b; b.bar = bar; b.x = xb_xcc_id(); b.st = st;
    if (threadIdx.x == 0) (void)xb_add(&bar[XB_XCNT(b.x)], 1u);
    return b;
}
__device__ __forceinline__ void xcd_barrier_complete(unsigned* bar, unsigned x, unsigned& nloc, unsigned& nx) {
    const unsigned G = gridDim.x * gridDim.y * gridDim.z;
    unsigned sum, cnt, mine, sp = 0u;
    for (;;) {
        sum = 0u; cnt = 0u; mine = 0u;
#pragma unroll
        for (unsigned j = 0; j < 16; ++j) { const unsigned c = xb_ld(&bar[XB_XCNT(j)]); sum += c; cnt += (c > 0u) ? 1u : 0u; mine = (j == x) ? c : mine; }
        if (sum == G) break;
        __builtin_amdgcn_s_sleep(1);
        if ((++sp & 255u) == 0u) { if (xb_ld(&bar[XB_TMO])) break; if (sp > XB_SPIN_CAP) { atomicAdd(&bar[XB_TMO], 1u); break; } }
    }
    nloc = mine > 0u ? mine : 1u; nx = cnt > 0u ? cnt : 1u;
}

__device__ __forceinline__ void xcd_barrier(const XcdBarrier& b) {
    asm volatile("s_waitcnt vmcnt(0)" ::: "memory");
    __syncthreads();
    if (threadIdx.x == 0) {
        unsigned* bar = b.bar;
        __builtin_amdgcn_s_waitcnt(0);
        unsigned nloc = b.st[0], nx = b.st[1];
        if (nloc == 0u) { xcd_barrier_complete(bar, b.x, nloc, nx); b.st[0] = nloc; b.st[1] = nx; }
        const unsigned old = xb_add(&bar[XB_XSUB(b.x)], 1u);
        const unsigned gen = old / nloc;
        if (old + 1u == (gen + 1u) * nloc) {
            __builtin_amdgcn_fence(__ATOMIC_RELEASE, "");
            asm volatile("s_waitcnt vmcnt(0)" ::: "memory");
            const unsigned og = xb_add(&bar[XB_TOP], 1u);
            const unsigned tg = og / nx;
            if (og + 1u == (tg + 1u) * nx) xb_add(&bar[XB_TOPGEN], 1u);
            else XB_SPIN(xb_ld(&bar[XB_TOPGEN]) == tg, bar);
            __builtin_amdgcn_fence(__ATOMIC_ACQUIRE, "");
            xb_add(&bar[XB_XGEN(b.x)], 1u);
            asm volatile("s_waitcnt vmcnt(0)" ::: "memory");
        } else {
            XB_SPIN(xb_ld(&bar[XB_XGEN(b.x)]) == gen, bar);
            __builtin_amdgcn_fence(__ATOMIC_ACQUIRE, "");
            asm volatile("s_waitcnt vmcnt(0)" ::: "memory");
        }
    }
    __syncthreads();
}

struct Params {
    const float *x, *g_mix, *w_in, *g_sgu, *sgu_w, *sgu_b, *w_a, *w_b, *w_out, *g_ffn, *wq, *subk, *ut, *vt, *g_fin;
    float* out; unsigned char* ws; int lo, hi;
};

__device__ __forceinline__ void p0_transpose_item(const float* W, int K, int N, bf16* WT, int ldw, LAS float* scr, int item, int lane, const float* gk, int qlo, int qhi) {
    const int nblk = N / 32, kb = item / nblk, nb = item % nblk, k0 = 64 * kb, n0 = 32 * nb;
    const float cs = (n0 >= qlo && n0 < qhi) ? 0.125f * 1.4426950408889634f : 1.0f;
    const int r = lane >> 3, c = lane & 7;
    f32x4 v[8];
#pragma unroll
    for (int i = 0; i < 8; ++i) v[i] = __builtin_nontemporal_load((const f32x4*)(W + (size_t)(k0 + 8 * i + r) * N + n0 + 4 * c));
    f32x4 g0 = {cs, cs, cs, cs}, g1 = g0;
    if (gk) { g0 = *(const f32x4*)(gk + k0 + 8 * c) * cs; g1 = *(const f32x4*)(gk + k0 + 8 * c + 4) * cs; }
#pragma unroll
    for (int i = 0; i < 8; ++i) { LAS float* d = scr + (8 * i + r) * 33 + 4 * c; d[0] = v[i][0]; d[1] = v[i][1]; d[2] = v[i][2]; d[3] = v[i][3]; }
    LDS_WAIT();
#pragma unroll
    for (int j = 0; j < 4; ++j) { const int n = (lane >> 3) + 8 * j; const LAS float* s = scr + (8 * c) * 33 + n;
        u32x4 o; o.x = pk2(s[0 * 33] * g0[0], s[1 * 33] * g0[1]); o.y = pk2(s[2 * 33] * g0[2], s[3 * 33] * g0[3]); o.z = pk2(s[4 * 33] * g1[0], s[5 * 33] * g1[1]); o.w = pk2(s[6 * 33] * g1[2], s[7 * 33] * g1[3]);
        *(u32x4*)(WT + (size_t)(n0 + n) * ldw + k0 + 8 * c) = o; }
    LDS_WAIT();
}
__device__ __forceinline__ void p0_convert(const float* src, bf16* dst, size_t n8, const float* g, int gl, int NGL) {
    for (size_t i = gl; i < n8; i += NGL) {
        const f32x4 a = *(const f32x4*)(src + i * 8), b = *(const f32x4*)(src + i * 8 + 4);
        f32x4 ga = {1.f, 1.f, 1.f, 1.f}, gb = ga;
        if (g) { const int d = (int)((i * 8) & 1023); ga = *(const f32x4*)(g + d); gb = *(const f32x4*)(g + d + 4); }
        u32x4 o; o.x = pk2(a[0] * ga[0], a[1] * ga[1]); o.y = pk2(a[2] * ga[2], a[3] * ga[3]); o.z = pk2(b[0] * gb[0], b[1] * gb[1]); o.w = pk2(b[2] * gb[2], b[3] * gb[3]);
        *(u32x4*)(dst + i * 8) = o;
    }
}
constexpr float UT_SCALE = 256.0f, VT_SCALE = 16.0f;
constexpr float V4_UNIT = 0.5f;
constexpr float U4_STEP = 0.3352f;
constexpr size_t SLICE_BYTES = (size_t)16384 * 128;
__device__ __forceinline__ unsigned pk4_fp8(const f32x4& v) { unsigned w = 0; w = __builtin_amdgcn_cvt_pk_fp8_f32(v[0], v[1], w, false); w = __builtin_amdgcn_cvt_pk_fp8_f32(v[2], v[3], w, true); return w; }
__device__ __forceinline__ void fp8_item_store(unsigned char* dst, size_t i, f32x4 a, f32x4 b, f32x4 c, f32x4 d, const float* g, float scale) {
    a *= scale; b *= scale; c *= scale; d *= scale;
    if (g) { const f32x4* gp = (const f32x4*)(g + ((i * 16) & 1023)); a *= gp[0]; b *= gp[1]; c *= gp[2]; d *= gp[3]; }
    u32x4 o; o.x = pk4_fp8(a); o.y = pk4_fp8(b); o.z = pk4_fp8(c); o.w = pk4_fp8(d);
    const size_t e = i >> 6, dg = i & 63;
    *(u32x4*)(dst + (dg >> 3) * ((size_t)16384 * 128) + e * 128 + (dg & 7) * 16) = o;
}
__device__ __forceinline__ void p0_prologue(const Params& P, LAS unsigned char* lds, int wave, int lane) {
    unsigned char* ws = P.ws;
    LAS float* scr = (LAS float*)(lds + wave * 16384);
    const int gw = blockIdx.x * NWAVES + wave, NGW = gridDim.x * NWAVES;
    constexpr int I_IN = (D / 64) * (INW / 32), I_A = (1024 / 64) * (1024 / 32), I_B = (512 / 64) * (1024 / 32), I_O = I_A, I_Q = (1024 / 64) * (2048 / 32);
    constexpr int NITEMS = I_IN + I_A + I_B + I_O + I_Q;
    for (int it = gw; it < NITEMS; it += NGW) {
        int r = it;
        if (r < I_IN) { p0_transpose_item(P.w_in, 1024, INW, (bf16*)(ws + WS_WIN), 1024, scr, r, lane, P.g_mix, 2048, 3584); continue; } r -= I_IN;
        if (r < I_A) { p0_transpose_item(P.w_a, 1024, 1024, (bf16*)(ws + WS_WA), 1536, scr, r, lane, nullptr, 0, 0); continue; } r -= I_A;
        if (r < I_B) { p0_transpose_item(P.w_b, 512, 1024, (bf16*)(ws + WS_WA) + 1024, 1536, scr, r, lane, nullptr, 0, 0); continue; } r -= I_B;
        if (r < I_O) { p0_transpose_item(P.w_out, 1024, 1024, (bf16*)(ws + WS_WO), 1024, scr, r, lane, nullptr, 0, 0); continue; } r -= I_O;
        p0_transpose_item(P.wq, 1024, 2048, (bf16*)(ws + WS_WQ), 1024, scr, r, lane, P.g_ffn, 0, 0);
    }
    const int gl = gw * 64 + lane, NGL = NGW * 64;
    p0_convert(P.subk, (bf16*)(ws + WS_SUBK), (size_t)16 * 128 * 128 / 8, nullptr, gl, NGL);
    p0_convert(P.sgu_w, (bf16*)(ws + WS_SGUW), (size_t)8 * 128 * 128 / 8, nullptr, gl, NGL);
    {
    for (int e = gw; e < 16384; e += NGW) {
        const float* src = P.ut + (size_t)e * 1024;
        f32x4 v[4]; float ssq = 0.f;
#pragma unroll
        for (int j = 0; j < 4; ++j) { v[j] = __builtin_nontemporal_load((const f32x4*)(src + 256 * j + 4 * lane)) * *(const f32x4*)(P.g_ffn + 256 * j + 4 * lane); ssq += (v[j][0] * v[j][0] + v[j][1] * v[j][1]) + (v[j][2] * v[j][2] + v[j][3] * v[j][3]); }
        ssq = wave_sum(ssq);
        const float step = U4_STEP * sqrtf(ssq * (1.0f / 1024.0f)) + 1e-30f, inv = 1.0f / step;
        LAS unsigned short* prow = (LAS unsigned short*)scr;
#pragma unroll
        for (int j = 0; j < 4; ++j) { unsigned q[4];
#pragma unroll
            for (int k = 0; k < 4; ++k) { int c = (int)floorf(v[j][k] * inv) + 8; c = c < 0 ? 0 : (c > 15 ? 15 : c); q[k] = (unsigned)c; }
            prow[64 * j + lane] = (unsigned short)(q[0] | (q[1] << 4) | (q[2] << 8) | (q[3] << 12)); }
        LDS_WAIT();
        const u32x2 w = *(const LAS u32x2*)((LAS unsigned char*)scr + 8 * lane);
        *(u32x2*)(ws + WS_UT + (size_t)(lane >> 4) * SLICE_BYTES + (size_t)e * 128 + 8 * (lane & 15)) = w;
        LDS_WAIT();
        if (lane == 0) ((float*)(ws + WS_UT + 4 * SLICE_BYTES))[2 * e] = step;
    }
    for (int e = gw; e < 16384; e += NGW) {
        const float* src = P.vt + (size_t)e * 1024;
        f32x4 v[4]; float ssq = 0.f;
#pragma unroll
        for (int j = 0; j < 4; ++j) { v[j] = __builtin_nontemporal_load((const f32x4*)(src + 256 * j + 4 * lane)); ssq += (v[j][0] * v[j][0] + v[j][1] * v[j][1]) + (v[j][2] * v[j][2] + v[j][3] * v[j][3]); }
        ssq = wave_sum(ssq);
        const float unit = V4_UNIT * sqrtf(ssq * (1.0f / 1024.0f)) + 1e-30f, inv = 1.0f / unit;
        LAS unsigned short* prow = (LAS unsigned short*)scr;
#pragma unroll
        for (int j = 0; j < 4; ++j) { unsigned w = 0;
            w = __builtin_amdgcn_cvt_scalef32_pk_fp4_f32(w, v[j][0] * inv, v[j][1] * inv, 1.0f, 0);
            w = __builtin_amdgcn_cvt_scalef32_pk_fp4_f32(w, v[j][2] * inv, v[j][3] * inv, 1.0f, 1);
            prow[64 * j + lane] = (unsigned short)w; }
        LDS_WAIT();
        const u32x2 w = *(const LAS u32x2*)((LAS unsigned char*)scr + 8 * lane);
        *(u32x2*)(ws + WS_VT + (size_t)(lane >> 4) * SLICE_BYTES + (size_t)e * 128 + 8 * (lane & 15)) = w;
        LDS_WAIT();
        if (lane == 0) ((float*)(ws + WS_UT + 4 * SLICE_BYTES))[2 * e + 1] = unit;
    }
    }
    bf16* XB = (bf16*)P.out; float* rstd1 = (float*)(ws + WS_RSTD1);
    for (int row = gw; row < T; row += NGW) {
        const f32x4* xr = (const f32x4*)(P.x + (size_t)row * D) + lane;
        f32x4 v[4]; float s = 0.f;
#pragma unroll
        for (int j = 0; j < 4; ++j) { v[j] = __builtin_nontemporal_load(xr + 64 * j); s += (v[j][0] * v[j][0] + v[j][1] * v[j][1]) + (v[j][2] * v[j][2] + v[j][3] * v[j][3]); }
        s = wave_sum(s);
        if (lane == 0) rstd1[row] = rsqrtf(s * (1.0f / D) + EPS);
        u32x2* o8 = (u32x2*)(XB + (size_t)row * D) + lane;
#pragma unroll
        for (int j = 0; j < 4; ++j) { u32x2 w; w.x = pk2(v[j][0], v[j][1]); w.y = pk2(v[j][2], v[j][3]); o8[64 * j] = w; }
    }
}

typedef short bf16x8_t __attribute__((ext_vector_type(8)));
typedef short s16x4_t __attribute__((ext_vector_type(4)));
__device__ __forceinline__ s16x4_t lds_tr16(LAS const unsigned char* p) { return __builtin_bit_cast(s16x4_t, __builtin_amdgcn_ds_read_tr16_b64_v4i16((LAS s16x4_t*)p)); }
__device__ __forceinline__ unsigned cvtpk(float lo, float hi) { f32x2 v = {lo, hi}; bf16x2_t b = __builtin_convertvector(v, bf16x2_t); return __builtin_bit_cast(unsigned, b); }
__device__ __forceinline__ void p2_sgu_mfma(const Params& P, LAS unsigned char* lds, int wave, int lane) {
    unsigned char* ws = P.ws;
    bf16* U = (bf16*)(ws + WS_UY); const bf16* GV = (const bf16*)(ws + WS_GV); const float* SS = (const float*)(ws + WS_SS);
    const bf16* SW = (const bf16*)(ws + WS_SGUW);
    constexpr int RP = 128;
    LAS float* rv = (LAS float*)(lds + LDS_MISC);
    LAS unsigned char* tile = lds + wave * (128 * RP);
    const int g = wave, fr = lane & 15, fq = lane >> 4, trq = (lane & 15) >> 2, trp = lane & 3;
    for (int ch = blockIdx.x; ch < T / 128; ch += gridDim.x) {
        const int t0 = ch * 128;
        __syncthreads();
        if (threadIdx.x < 128) { const float* sp = SS + (size_t)(t0 + threadIdx.x) * 16; float s = 0.f;
#pragma unroll
            for (int i = 0; i < 16; ++i) s += sp[i];
            rv[threadIdx.x] = rsqrtf(s * (1.0f / 1024.f) + EPS); }
        __syncthreads();
#pragma unroll 1
        for (int half = 0; half < 2; ++half) {
            const int c0 = g * 128 + half * 64;
            LDS_WAIT();
#pragma unroll
            for (int it = 0; it < 16; ++it) { const int s = it * 8 + (lane >> 3), ck = lane & 7;
                const u32x4 v = __builtin_nontemporal_load((const u32x4*)(GV + ((size_t)((t0 + s) >> 4) * 32 + (c0 >> 5) + (ck >> 2)) * 512 + ((ck & 3) * 16 + (s & 15)) * 8)); const float r = rv[s];
                u32x4 o; o.x = cvtpk(bflo(v.x) * r, bfhi(v.x) * r); o.y = cvtpk(bflo(v.y) * r, bfhi(v.y) * r); o.z = cvtpk(bflo(v.z) * r, bfhi(v.z) * r); o.w = cvtpk(bflo(v.w) * r, bfhi(v.w) * r);
                *(LAS u32x4*)(tile + s * RP + ck * 16) = o; }
            LDS_WAIT();
            bf16x8_t bfr[4][4];
#pragma unroll
            for (int ks = 0; ks < 4; ++ks)
#pragma unroll
                for (int nt = 0; nt < 4; ++nt) {
                    const s16x4_t lo = lds_tr16(tile + (32 * ks + 8 * fq + trq) * RP + nt * 32 + trp * 8);
                    const s16x4_t hi = lds_tr16(tile + (32 * ks + 8 * fq + 4 + trq) * RP + nt * 32 + trp * 8);
                    bfr[ks][nt] = (bf16x8_t){lo[0], lo[1], lo[2], lo[3], hi[0], hi[1], hi[2], hi[3]}; }
            const bf16* swp = SW + ((size_t)g * 128 + fr) * 128 + fq * 8;
            bf16x8_t afr[4], afn[4];
            bf16* up0 = U + (size_t)(t0 + fr) * UYP + c0 + 4 * fq;
            u32x2 uu[4], un[4]; float bb, bbn; f32x4 gsv[4];
#pragma unroll
            for (int ks = 0; ks < 4; ++ks) afr[ks] = *(const bf16x8_t*)(swp + ks * 32);
#pragma unroll
            for (int nt = 0; nt < 4; ++nt) uu[nt] = *(const u32x2*)(up0 + nt * 16);
            bb = P.sgu_b[g * 128 + fr];
#pragma unroll
            for (int nt = 0; nt < 4; ++nt) gsv[nt] = *(const f32x4*)(P.g_sgu + c0 + nt * 16 + 4 * fq);
#pragma unroll 1
            for (int mt = 0; mt < 8; ++mt) {
                const int mn = mt < 7 ? mt + 1 : 7;
#pragma unroll
                for (int ks = 0; ks < 4; ++ks) afn[ks] = *(const bf16x8_t*)(swp + (size_t)mn * 16 * 128 + ks * 32);
#pragma unroll
                for (int nt = 0; nt < 4; ++nt) un[nt] = *(const u32x2*)(up0 + (size_t)mn * 16 * UYP + nt * 16);
                bbn = P.sgu_b[g * 128 + mn * 16 + fr];
                bf16* up = up0 + (size_t)mt * 16 * UYP;
                f32x4 acc[4];
#pragma unroll
                for (int nt = 0; nt < 4; ++nt) acc[nt] = (f32x4){0.f, 0.f, 0.f, 0.f};
#pragma unroll
                for (int ks = 0; ks < 4; ++ks)
#pragma unroll
                    for (int nt = 0; nt < 4; ++nt) acc[nt] = __builtin_amdgcn_mfma_f32_16x16x32_bf16(bfr[ks][nt], afr[ks], acc[nt], 0, 0, 0);
#pragma unroll
                for (int nt = 0; nt < 4; ++nt) { const f32x4 gs = gsv[nt]; const f32x4 a = acc[nt];
                    u32x2 o; o.x = cvtpk(bflo(uu[nt].x) * (gs[0] * a[0] + bb), bfhi(uu[nt].x) * (gs[1] * a[1] + bb)); o.y = cvtpk(bflo(uu[nt].y) * (gs[2] * a[2] + bb), bfhi(uu[nt].y) * (gs[3] * a[3] + bb));
                    *(u32x2*)(up + nt * 16) = o; }
#pragma unroll
                for (int ks = 0; ks < 4; ++ks) afr[ks] = afn[ks];
#pragma unroll
                for (int nt = 0; nt < 4; ++nt) uu[nt] = un[nt];
                bb = bbn;
            }
        }
    }
}

typedef float f32x16 __attribute__((ext_vector_type(16)));
constexpr int VRP = 192;
constexpr int KRP = 144;
template <int G>
__device__ __forceinline__ void attn_qtile(const bf16* __restrict__ Q, const bf16* __restrict__ Kb, const bf16* __restrict__ Vb, bf16* OGg, float* LSEg,
                                           LAS unsigned char* vt, LAS unsigned char* ktl, int b, int h, int r, int m0, int lane) {
    constexpr int d = (G == 0) ? 1 : (G == 1 ? 4 : 16), Mlen = SEQ / d;
    const int j = lane & 31, hi = lane >> 5;
    const float nsl2 = -exp2f(-(float)(h + 1)) * (float)d * 1.4426950408889634f;
    const size_t qpos = (size_t)b * SEQ + (size_t)(m0 + j) * d + r;
    bf16x8_t qf[4];
    { u32x4 qr[4];
#pragma unroll
      for (int q4 = 0; q4 < 4; ++q4) qr[q4] = *(const u32x4*)(Q + ((size_t)b * SEQ + (size_t)(m0 + q4 * 8 + (lane >> 3)) * d + r) * 1536 + G * 512 + h * 64 + (lane & 7) * 8);
      LDS_WAIT();
#pragma unroll
      for (int q4 = 0; q4 < 4; ++q4) *(LAS u32x4*)(ktl + (q4 * 8 + (lane >> 3)) * KRP + (lane & 7) * 16) = qr[q4];
      LDS_WAIT();
#pragma unroll
      for (int ks = 0; ks < 4; ++ks) qf[ks] = *(const LAS bf16x8_t*)(ktl + j * KRP + (2 * ks + hi) * 16);
      LDS_WAIT(); }
    float m_run = -__builtin_inff(), l_run = 0.f;
    f32x16 o0, o1;
#pragma unroll
    for (int i = 0; i < 16; ++i) { o0[i] = 0.f; o1[i] = 0.f; }
    const int trq = (lane & 15) >> 2, trp = lane & 3, blk = (lane >> 4) & 1;
    LAS const unsigned char* trbase = vt + (4 * hi + trq) * VRP + blk * 32 + trp * 8;
#define ATT_LOAD(KR, VR, oi_) do { const int kt_ = 2 + (((oi_) + 1) >> 1) * (((oi_) & 1) ? -1 : 1), kb_ = m0 - 64 + 32 * kt_; \
        _Pragma("unroll") for (int q4 = 0; q4 < 4; ++q4) { int km = kb_ + q4 * 8 + (lane >> 3); km = km < 0 ? 0 : (km >= Mlen ? Mlen - 1 : km); \
            const size_t ro_ = ((size_t)b * SEQ + (size_t)km * d + r) * 512 + h * 64 + (lane & 7) * 8; \
            KR[q4] = *(const u32x4*)(Kb + ro_); VR[q4] = *(const u32x4*)(Vb + ro_); } } while (0)
    u32x4 kr[4], krn[4], vr[4], vrn[4];
    ATT_LOAD(kr, vr, 0);
#pragma unroll 1
    for (int oi = 0; oi < 5; ++oi) {
        const int kt = 2 + ((oi + 1) >> 1) * ((oi & 1) ? -1 : 1);
        const int kb = m0 - 64 + 32 * kt;
        if (oi < 4) ATT_LOAD(krn, vrn, oi + 1);
        LDS_WAIT();
#pragma unroll
        for (int q4 = 0; q4 < 4; ++q4) { *(LAS u32x4*)(ktl + (q4 * 8 + (lane >> 3)) * KRP + (lane & 7) * 16) = kr[q4]; *(LAS u32x4*)(vt + (q4 * 8 + (lane >> 3)) * VRP + (lane & 7) * 16) = vr[q4]; }
        LDS_WAIT();
        bf16x8_t kf[4];
#pragma unroll
        for (int ks = 0; ks < 4; ++ks) kf[ks] = *(const LAS bf16x8_t*)(ktl + j * KRP + (2 * ks + hi) * 16);
        f32x16 sacc;
#pragma unroll
        for (int i = 0; i < 16; ++i) sacc[i] = 0.f;
#pragma unroll
        for (int ks = 0; ks < 4; ++ks) sacc = __builtin_amdgcn_mfma_f32_32x32x16_bf16(kf[ks], qf[ks], sacc, 0, 0, 0);
        const float relbase = (float)(32 * kt - 64 + 4 * hi - j);
        const bool edge = (kb < 0) || (kb + 31 >= Mlen);
        float sv[16]; float tmax = -__builtin_inff();
#pragma unroll
        for (int rr = 0; rr < 16; ++rr) {
            const int ci = (rr & 3) + 8 * (rr >> 2);
            const float arel = fabsf(relbase + (float)ci);
            float s2 = fmaf(arel, nsl2, sacc[rr]);
            s2 = (arel <= 64.0f) ? s2 : -__builtin_inff();
            if (edge) { const int km = kb + ci + 4 * hi; s2 = (km >= 0 && km < Mlen) ? s2 : -__builtin_inff(); }
            sv[rr] = s2; tmax = fmaxf(tmax, s2);
        }
        tmax = fmaxf(tmax, __shfl_xor(tmax, 32));
        const float m_new = fmaxf(m_run, tmax);
        const float alpha = __builtin_amdgcn_exp2f(m_run - m_new);
        m_run = m_new;
        float lsum = 0.f;
#pragma unroll
        for (int rr = 0; rr < 16; ++rr) { sv[rr] = __builtin_amdgcn_exp2f(sv[rr] - m_new); lsum += sv[rr]; }
        l_run = l_run * alpha + lsum;
#pragma unroll
        for (int i = 0; i < 16; ++i) { o0[i] *= alpha; o1[i] *= alpha; }
        bf16x8_t pb[2];
#pragma unroll
        for (int s2i = 0; s2i < 2; ++s2i) { u32x4 w; w.x = cvtpk(sv[8 * s2i], sv[8 * s2i + 1]); w.y = cvtpk(sv[8 * s2i + 2], sv[8 * s2i + 3]); w.z = cvtpk(sv[8 * s2i + 4], sv[8 * s2i + 5]); w.w = cvtpk(sv[8 * s2i + 6], sv[8 * s2i + 7]);
            pb[s2i] = __builtin_bit_cast(bf16x8_t, w); }
#pragma unroll
        for (int s2i = 0; s2i < 2; ++s2i) {
#pragma unroll
            for (int c = 0; c < 2; ++c) {
                const s16x4_t lo = lds_tr16(trbase + (16 * s2i) * VRP + c * 64);
                const s16x4_t hh = lds_tr16(trbase + (16 * s2i + 8) * VRP + c * 64);
                const bf16x8_t vf = (bf16x8_t){lo[0], lo[1], lo[2], lo[3], hh[0], hh[1], hh[2], hh[3]};
                if (c == 0) o0 = __builtin_amdgcn_mfma_f32_32x32x16_bf16(vf, pb[s2i], o0, 0, 0, 0);
                else o1 = __builtin_amdgcn_mfma_f32_32x32x16_bf16(vf, pb[s2i], o1, 0, 0, 0);
            }
        }
#pragma unroll
        for (int i = 0; i < 4; ++i) { kr[i] = krn[i]; vr[i] = vrn[i]; }
    }
#undef ATT_LOAD
    const float l_tot = l_run + __shfl_xor(l_run, 32);
    const float inv = 1.0f / l_tot;
    LDS_WAIT();
#pragma unroll
    for (int g4 = 0; g4 < 4; ++g4) {
        u32x2 w0, w1;
        w0.x = cvtpk(o0[4 * g4] * inv, o0[4 * g4 + 1] * inv); w0.y = cvtpk(o0[4 * g4 + 2] * inv, o0[4 * g4 + 3] * inv);
        w1.x = cvtpk(o1[4 * g4] * inv, o1[4 * g4 + 1] * inv); w1.y = cvtpk(o1[4 * g4 + 2] * inv, o1[4 * g4 + 3] * inv);
        *(LAS u32x2*)(ktl + j * KRP + (8 * g4 + 4 * hi) * 2) = w0; *(LAS u32x2*)(ktl + j * KRP + (32 + 8 * g4 + 4 * hi) * 2) = w1;
    }
    LDS_WAIT();
#pragma unroll
    for (int q4 = 0; q4 < 4; ++q4) { const int jr = q4 * 8 + (lane >> 3);
        const u32x4 v = *(const LAS u32x4*)(ktl + jr * KRP + (lane & 7) * 16);
        *(u32x4*)(OGg + ((size_t)b * SEQ + (size_t)(m0 + jr) * d + r) * 512 + h * 64 + (lane & 7) * 8) = v; }
    if (hi == 0) LSEg[((size_t)b * 8 + h) * SEQ + (size_t)(m0 + j) * d + r] = m_run + __builtin_amdgcn_logf(l_tot);
}
struct AttnSt { float m, l; f32x16 o0, o1; };
__device__ __forceinline__ float xhalf_max(float v) { const auto r = __builtin_amdgcn_permlane32_swap(__float_as_uint(v), __float_as_uint(v), false, false); return fmaxf(__uint_as_float(r[0]), __uint_as_float(r[1])); }
__device__ __forceinline__ float xhalf_sum(float v) { const auto r = __builtin_amdgcn_permlane32_swap(__float_as_uint(v), __float_as_uint(v), false, false); return __uint_as_float(r[0]) + __uint_as_float(r[1]); }
constexpr float RESCALE_THR = 8.0f;
template <int G>
__device__ __forceinline__ void attn_tile_update(AttnSt& st, const bf16x8_t (&qf)[4], const bf16x8_t (&kf)[4], const bf16x8_t (&vf)[2][2], int kt, int kb, int j, int hi, float nsl2) {
    constexpr int d = (G == 0) ? 1 : (G == 1 ? 4 : 16), Mlen = SEQ / d;
    f32x16 sacc;
#pragma unroll
    for (int i = 0; i < 16; ++i) sacc[i] = 0.f;
#pragma unroll
    for (int ks = 0; ks < 4; ++ks) sacc = __builtin_amdgcn_mfma_f32_32x32x16_bf16(kf[ks], qf[ks], sacc, 0, 0, 0);
    float relbase = (float)(32 * kt - 64 + 4 * hi - j);
    asm volatile("" : "+v"(relbase));
    const bool edge = (kb < 0) || (kb + 31 >= Mlen);
    float sv[16]; float tmax = -__builtin_inff();
#pragma unroll
    for (int rr = 0; rr < 16; ++rr) { const int ci = (rr & 3) + 8 * (rr >> 2); sv[rr] = fmaf(fabsf(relbase + (float)ci), nsl2, sacc[rr]); }
    if (kt == 0 || kt == 4) {
        asm volatile("" : "+v"(relbase));
#pragma unroll
        for (int rr = 0; rr < 16; ++rr) { const int ci = (rr & 3) + 8 * (rr >> 2); sv[rr] = (fabsf(relbase + (float)ci) <= 64.0f) ? sv[rr] : -__builtin_inff(); }
    }
    if (edge) {
        int kbl = kb + 4 * hi; asm volatile("" : "+v"(kbl));
#pragma unroll
        for (int rr = 0; rr < 16; ++rr) { const int km = kbl + (rr & 3) + 8 * (rr >> 2); sv[rr] = (km >= 0 && km < Mlen) ? sv[rr] : -__builtin_inff(); }
    }
#pragma unroll
    for (int rr = 0; rr < 16; ++rr) tmax = fmaxf(tmax, sv[rr]);
    tmax = xhalf_max(tmax);
    if (!__all(tmax - st.m <= RESCALE_THR)) {
        const float m_new = fmaxf(st.m, tmax);
        const float alpha = __builtin_amdgcn_exp2f(st.m - m_new);
        st.m = m_new; st.l *= alpha;
#pragma unroll
        for (int i = 0; i < 16; ++i) { st.o0[i] *= alpha; st.o1[i] *= alpha; }
    }
    const float mcur = st.m;
    float lsum = 0.f;
#pragma unroll
    for (int rr = 0; rr < 16; ++rr) { sv[rr] = __builtin_amdgcn_exp2f(sv[rr] - mcur); lsum += sv[rr]; }
    st.l += lsum;
#pragma unroll
    for (int s2i = 0; s2i < 2; ++s2i) { u32x4 w; w.x = cvtpk(sv[8 * s2i], sv[8 * s2i + 1]); w.y = cvtpk(sv[8 * s2i + 2], sv[8 * s2i + 3]); w.z = cvtpk(sv[8 * s2i + 4], sv[8 * s2i + 5]); w.w = cvtpk(sv[8 * s2i + 6], sv[8 * s2i + 7]);
        const bf16x8_t pb = __builtin_bit_cast(bf16x8_t, w);
        st.o0 = __builtin_amdgcn_mfma_f32_32x32x16_bf16(vf[s2i][0], pb, st.o0, 0, 0, 0);
        st.o1 = __builtin_amdgcn_mfma_f32_32x32x16_bf16(vf[s2i][1], pb, st.o1, 0, 0, 0); }
}
template <int G>
__device__ __forceinline__ void attn_qpair(const bf16* __restrict__ Q, const bf16* __restrict__ Kb, const bf16* __restrict__ Vb, bf16* OGg, float* LSEg, bf16* YBp,
                                           LAS unsigned char* vt, LAS unsigned char* ktl, int b, int h, int r, int m0, int lane) {
    constexpr int d = (G == 0) ? 1 : (G == 1 ? 4 : 16), Mlen = SEQ / d;
    asm volatile("" : "+v"(lane));
    const int j = lane & 31, hi = lane >> 5;
    const float nsl2 = -exp2f(-(float)(h + 1)) * (float)d * 1.4426950408889634f;
#define ATT_KTP(oi_) (((oi_) & 1) ? 3 + ((oi_) >> 1) : 2 - ((oi_) >> 1))
#define ATT_LOAD2(KR, VR, ktp_) do { const int kb_ = m0 - 64 + 32 * (ktp_); \
        _Pragma("unroll") for (int q4 = 0; q4 < 4; ++q4) { int km = kb_ + q4 * 8 + (lane >> 3); km = km < 0 ? 0 : (km >= Mlen ? Mlen - 1 : km); \
            const size_t ro_ = ((size_t)b * SEQ + (size_t)km * d + r) * 512 + h * 64 + (lane & 7) * 8; \
            KR[q4] = *(const u32x4*)(Kb + ro_); VR[q4] = *(const u32x4*)(Vb + ro_); } } while (0)
    bf16x8_t qfA[4], qfB[4];
    u32x4 kr[4], vr[4];
    { u32x4 qa[4], qb[4];
#pragma unroll
      for (int q4 = 0; q4 < 4; ++q4) qa[q4] = __builtin_nontemporal_load((const u32x4*)(Q + ((size_t)b * SEQ + (size_t)(m0 + q4 * 8 + (lane >> 3)) * d + r) * 1536 + G * 512 + h * 64 + (lane & 7) * 8));
#pragma unroll
      for (int q4 = 0; q4 < 4; ++q4) qb[q4] = __builtin_nontemporal_load((const u32x4*)(Q + ((size_t)b * SEQ + (size_t)(m0 + 32 + q4 * 8 + (lane >> 3)) * d + r) * 1536 + G * 512 + h * 64 + (lane & 7) * 8));
      ATT_LOAD2(kr, vr, 2);
      LDS_WAIT();
#pragma unroll
      for (int q4 = 0; q4 < 4; ++q4) { *(LAS u32x4*)(ktl + (q4 * 8 + (lane >> 3)) * KRP + (lane & 7) * 16) = qa[q4]; *(LAS u32x4*)(vt + (q4 * 8 + (lane >> 3)) * VRP + (lane & 7) * 16) = qb[q4]; }
      LDS_WAIT();
#pragma unroll
      for (int ks = 0; ks < 4; ++ks) { qfA[ks] = *(const LAS bf16x8_t*)(ktl + j * KRP + (2 * ks + hi) * 16); qfB[ks] = *(const LAS bf16x8_t*)(vt + j * VRP + (2 * ks + hi) * 16); }
      LDS_WAIT(); }
    AttnSt A, B;
    A.m = -__builtin_inff(); A.l = 0.f; B.m = -__builtin_inff(); B.l = 0.f;
#pragma unroll
    for (int i = 0; i < 16; ++i) { A.o0[i] = 0.f; A.o1[i] = 0.f; B.o0[i] = 0.f; B.o1[i] = 0.f; }
    const int trq = (lane & 15) >> 2, trp = lane & 3, blk = (lane >> 4) & 1;
    LAS const unsigned char* trbase = vt + (4 * hi + trq) * VRP + blk * 32 + trp * 8;
#define ATT_STAGE(oi_) \
        LDS_WAIT(); \
        _Pragma("unroll") for (int q4 = 0; q4 < 4; ++q4) { *(LAS u32x4*)(ktl + (q4 * 8 + (lane >> 3)) * KRP + (lane & 7) * 16) = kr[q4]; *(LAS u32x4*)(vt + (q4 * 8 + (lane >> 3)) * VRP + (lane & 7) * 16) = vr[q4]; } \
        if ((oi_) < 5) ATT_LOAD2(kr, vr, ATT_KTP((oi_) + 1)); \
        LDS_WAIT(); \
        bf16x8_t kf[4]; bf16x8_t vf[2][2]; \
        _Pragma("unroll") for (int ks = 0; ks < 4; ++ks) kf[ks] = *(const LAS bf16x8_t*)(ktl + j * KRP + (2 * ks + hi) * 16); \
        _Pragma("unroll") for (int s2i = 0; s2i < 2; ++s2i) _Pragma("unroll") for (int c = 0; c < 2; ++c) { \
            const s16x4_t lo = lds_tr16(trbase + (16 * s2i) * VRP + c * 64); const s16x4_t hh = lds_tr16(trbase + (16 * s2i + 8) * VRP + c * 64); \
            vf[s2i][c] = (bf16x8_t){lo[0], lo[1], lo[2], lo[3], hh[0], hh[1], hh[2], hh[3]}; }
#pragma unroll 1
    for (int oi = 0; oi < 4; ++oi) {
        const int ktp = ATT_KTP(oi), kb = m0 - 64 + 32 * ktp;
        ATT_STAGE(oi)
        attn_tile_update<G>(A, qfA, kf, vf, ktp, kb, j, hi, nsl2);
        attn_tile_update<G>(B, qfB, kf, vf, ktp - 1, kb, j, hi, nsl2);
    }
    { const int kb = m0 - 64;
      ATT_STAGE(4)
      attn_tile_update<G>(A, qfA, kf, vf, 0, kb, j, hi, nsl2); }
    u32x4 gA1[4], gA2[4], gB1[4], gB2[4]; float lA1 = 0.f, lA2 = 0.f, lB1 = 0.f, lB2 = 0.f;
#define ATT_G0_LOAD(G1, G2, L1, L2, mq) do { const size_t li_ = ((size_t)b * 8 + h) * SEQ + (size_t)((mq) + j); L1 = LSEg[(size_t)T * 8 + li_]; L2 = LSEg[(size_t)2 * T * 8 + li_]; \
      _Pragma("unroll") for (int q4 = 0; q4 < 4; ++q4) { const size_t off_ = ((size_t)b * SEQ + (size_t)((mq) + q4 * 8 + (lane >> 3))) * 512 + h * 64 + (lane & 7) * 8; \
        G1[q4] = *(const u32x4*)(OGg + (size_t)T * 512 + off_); G2[q4] = *(const u32x4*)(OGg + (size_t)2 * T * 512 + off_); } } while (0)
    if constexpr (G == 0) ATT_G0_LOAD(gA1, gA2, lA1, lA2, m0);
    { const int kb = m0 - 64 + 160;
      ATT_STAGE(5)
      attn_tile_update<G>(B, qfB, kf, vf, 4, kb, j, hi, nsl2); }
#undef ATT_STAGE
#undef ATT_LOAD2
#undef ATT_KTP
#define ATT_FIN(ST, mq) do { const float l_tot = xhalf_sum(ST.l); const float inv = 1.0f / l_tot; \
      LDS_WAIT(); \
      _Pragma("unroll") for (int g4 = 0; g4 < 4; ++g4) { u32x2 w0, w1; \
        w0.x = cvtpk(ST.o0[4 * g4] * inv, ST.o0[4 * g4 + 1] * inv); w0.y = cvtpk(ST.o0[4 * g4 + 2] * inv, ST.o0[4 * g4 + 3] * inv); \
        w1.x = cvtpk(ST.o1[4 * g4] * inv, ST.o1[4 * g4 + 1] * inv); w1.y = cvtpk(ST.o1[4 * g4 + 2] * inv, ST.o1[4 * g4 + 3] * inv); \
        *(LAS u32x2*)(ktl + j * KRP + (8 * g4 + 4 * hi) * 2) = w0; *(LAS u32x2*)(ktl + j * KRP + (32 + 8 * g4 + 4 * hi) * 2) = w1; } \
      LDS_WAIT(); \
      _Pragma("unroll") for (int q4 = 0; q4 < 4; ++q4) { const int jr = q4 * 8 + (lane >> 3); \
        const u32x4 v = *(const LAS u32x4*)(ktl + jr * KRP + (lane & 7) * 16); \
        *(u32x4*)(OGg + ((size_t)b * SEQ + (size_t)((mq) + jr) * d + r) * 512 + h * 64 + (lane & 7) * 8) = v; } \
      if (hi == 0) LSEg[((size_t)b * 8 + h) * SEQ + (size_t)((mq) + j) * d + r] = ST.m + __builtin_amdgcn_logf(l_tot); } while (0)
#define ATT_FIN0(ST, mq, g1_, g2_, l1_, l2_) do { const float l_tot = xhalf_sum(ST.l); \
      const float l0_ = ST.m + __builtin_amdgcn_logf(l_tot); \
      const float mx_ = fmaxf(l0_, fmaxf(l1_, l2_)); \
      const float w0_ = __builtin_amdgcn_exp2f(l0_ - mx_); float w1_ = __builtin_amdgcn_exp2f(l1_ - mx_), w2_ = __builtin_amdgcn_exp2f(l2_ - mx_); \
      const float iw_ = 1.0f / (w0_ + w1_ + w2_); const float inv = w0_ * iw_ / l_tot; w1_ *= iw_; w2_ *= iw_; \
      LDS_WAIT(); \
      _Pragma("unroll") for (int g4 = 0; g4 < 4; ++g4) { u32x2 w0, w1; \
        w0.x = cvtpk(ST.o0[4 * g4] * inv, ST.o0[4 * g4 + 1] * inv); w0.y = cvtpk(ST.o0[4 * g4 + 2] * inv, ST.o0[4 * g4 + 3] * inv); \
        w1.x = cvtpk(ST.o1[4 * g4] * inv, ST.o1[4 * g4 + 1] * inv); w1.y = cvtpk(ST.o1[4 * g4 + 2] * inv, ST.o1[4 * g4 + 3] * inv); \
        *(LAS u32x2*)(ktl + j * KRP + (8 * g4 + 4 * hi) * 2) = w0; *(LAS u32x2*)(ktl + j * KRP + (32 + 8 * g4 + 4 * hi) * 2) = w1; } \
      if (hi == 0) *(LAS f32x2*)(ktl + j * KRP + 128) = (f32x2){w1_, w2_}; \
      LDS_WAIT(); \
      _Pragma("unroll") for (int q4 = 0; q4 < 4; ++q4) { const int jr = q4 * 8 + (lane >> 3); \
        const u32x4 v = *(const LAS u32x4*)(ktl + jr * KRP + (lane & 7) * 16); const f32x2 ww_ = *(const LAS f32x2*)(ktl + jr * KRP + 128); \
        const u32x4 a_ = g1_[q4], c_ = g2_[q4]; u32x4 o_; \
        o_.x = cvtpk(bflo(v.x) + ww_.x * bflo(a_.x) + ww_.y * bflo(c_.x), bfhi(v.x) + ww_.x * bfhi(a_.x) + ww_.y * bfhi(c_.x)); \
        o_.y = cvtpk(bflo(v.y) + ww_.x * bflo(a_.y) + ww_.y * bflo(c_.y), bfhi(v.y) + ww_.x * bfhi(a_.y) + ww_.y * bfhi(c_.y)); \
        o_.z = cvtpk(bflo(v.z) + ww_.x * bflo(a_.z) + ww_.y * bflo(c_.z), bfhi(v.z) + ww_.x * bfhi(a_.z) + ww_.y * bfhi(c_.z)); \
        o_.w = cvtpk(bflo(v.w) + ww_.x * bflo(a_.w) + ww_.y * bflo(c_.w), bfhi(v.w) + ww_.x * bfhi(a_.w) + ww_.y * bfhi(c_.w)); \
        *(u32x4*)(YBp + ((size_t)b * SEQ + (size_t)((mq) + jr)) * UYP + h * 64 + (lane & 7) * 8) = o_; } } while (0)
    if constexpr (G == 0) { ATT_G0_LOAD(gB1, gB2, lB1, lB2, m0 + 32); ATT_FIN0(A, m0, gA1, gA2, lA1, lA2); ATT_FIN0(B, m0 + 32, gB1, gB2, lB1, lB2); }
    else { ATT_FIN(A, m0); ATT_FIN(B, m0 + 32); }
#undef ATT_FIN0
#undef ATT_G0_LOAD
#undef ATT_FIN
}
__device__ __forceinline__ void p2_attn_mfma(const Params& P, LAS unsigned char* lds, int wave, int lane) {
    unsigned char* ws = P.ws;
    const bf16* Q = (const bf16*)(ws + WS_Q); const bf16* Kb = (const bf16*)(ws + WS_K); const bf16* Vb = (const bf16*)(ws + WS_V);
    bf16* YB = (bf16*)(ws + WS_UY) + 1024;
    bf16* OG = (bf16*)((unsigned char*)P.out + 32 * MiB);
    float* LSE = (float*)(ws + WS_LSE);
    LAS unsigned char* vt = lds + wave * (32 * VRP + 32 * KRP); LAS unsigned char* ktl = vt + 32 * VRP;
    for (int unit = blockIdx.x; unit < BATCH * 8 * (SEQ / 1024); unit += gridDim.x) {
        const int b = unit >> 6, h = (unit >> 3) & 7, s0 = (unit & 7) * 1024;
#pragma unroll 1
        for (int i = 0; i < 4; i += 2) { const int ti = wave * 4 + i;
            attn_qpair<1>(Q, Kb, Vb, OG + (size_t)T * 512, LSE + (size_t)T * 8, YB, vt, ktl, b, h, ti >> 3, s0 / 4 + (ti & 7) * 32, lane); }
#pragma unroll 1
        for (int i = 0; i < 4; i += 2) { const int ti = wave * 4 + i;
            attn_qpair<2>(Q, Kb, Vb, OG + (size_t)2 * T * 512, LSE + (size_t)2 * T * 8, YB, vt, ktl, b, h, ti >> 1, s0 / 16 + (ti & 1) * 32, lane); }
        __syncthreads();
#pragma unroll 1
        for (int i = 0; i < 4; i += 2) { const int ti = wave * 4 + i;
            attn_qpair<0>(Q, Kb, Vb, OG, LSE, YB, vt, ktl, b, h, 0, s0 + ti * 32, lane); }
        __syncthreads();
    }
}

__device__ __forceinline__ float sel4f(bool b0, bool b1, float a, float b, float c, float d) { const float lo = b0 ? b : a, hi = b0 ? d : c; return b1 ? hi : lo; }
__device__ __forceinline__ unsigned sel4u(bool b0, bool b1, unsigned a, unsigned b, unsigned c, unsigned d) { const unsigned lo = b0 ? b : a, hi = b0 ? d : c; return b1 ? hi : lo; }
#define CE_D(a, b) do { const float hi_ = fmaxf(a, b), lo_ = fminf(a, b); a = hi_; b = lo_; } while (0)
__device__ __forceinline__ void bitonic_merge16(float (&v)[16]) {
#pragma unroll
    for (int js = 3; js >= 0; --js) { const int j = 1 << js;
#pragma unroll
        for (int i = 0; i < 16; ++i) { const int l = i ^ j; if (l > i) CE_D(v[i], v[l]); } }
}
__device__ __forceinline__ void bitonic_sort16(float (&v)[16]) {
    CE_D(v[0], v[13]); CE_D(v[1], v[12]); CE_D(v[2], v[15]); CE_D(v[3], v[14]); CE_D(v[4], v[8]); CE_D(v[5], v[6]); CE_D(v[7], v[11]); CE_D(v[9], v[10]);
    CE_D(v[0], v[5]); CE_D(v[1], v[7]); CE_D(v[2], v[9]); CE_D(v[3], v[4]); CE_D(v[6], v[13]); CE_D(v[8], v[14]); CE_D(v[10], v[15]); CE_D(v[11], v[12]);
    CE_D(v[0], v[1]); CE_D(v[2], v[3]); CE_D(v[4], v[5]); CE_D(v[6], v[8]); CE_D(v[7], v[9]); CE_D(v[10], v[11]); CE_D(v[12], v[13]); CE_D(v[14], v[15]);
    CE_D(v[0], v[2]); CE_D(v[1], v[3]); CE_D(v[4], v[10]); CE_D(v[5], v[11]); CE_D(v[6], v[7]); CE_D(v[8], v[9]); CE_D(v[12], v[14]); CE_D(v[13], v[15]);
    CE_D(v[1], v[2]); CE_D(v[3], v[12]); CE_D(v[4], v[6]); CE_D(v[5], v[7]); CE_D(v[8], v[10]); CE_D(v[9], v[11]); CE_D(v[13], v[14]); CE_D(v[1], v[4]);
    CE_D(v[2], v[6]); CE_D(v[5], v[8]); CE_D(v[7], v[10]); CE_D(v[9], v[13]); CE_D(v[11], v[14]); CE_D(v[2], v[4]); CE_D(v[3], v[6]); CE_D(v[9], v[12]);
    CE_D(v[11], v[13]); CE_D(v[3], v[5]); CE_D(v[6], v[8]); CE_D(v[7], v[9]); CE_D(v[10], v[12]); CE_D(v[3], v[4]); CE_D(v[5], v[6]); CE_D(v[7], v[8]);
    CE_D(v[9], v[10]); CE_D(v[11], v[12]); CE_D(v[6], v[7]); CE_D(v[8], v[9]);
}
__device__ __forceinline__ void xlane_top16(float (&c)[16], int o) {
    float tmp[16];
#pragma unroll
    for (int i = 0; i < 16; ++i) tmp[i] = __shfl_xor(c[15 - i], o);
#pragma unroll
    for (int i = 0; i < 16; ++i) c[i] = fmaxf(c[i], tmp[i]);
    bitonic_merge16(c);
}
__device__ __forceinline__ float pk_idx(float x, unsigned n) { return __uint_as_float((__float_as_uint(x) & ~127u) | n); }
constexpr int SKP = 272;
typedef _Float16 h2p_t __attribute__((ext_vector_type(2)));
__device__ __forceinline__ unsigned pk_h2(float a, float b) { const h2p_t h = {(_Float16)a, (_Float16)b}; return __builtin_bit_cast(unsigned, h); }
template <int MODE>
__device__ __forceinline__ void p6_topk_mfma(const Params& P, LAS unsigned char* lds, int wave, int lane) {
    unsigned char* ws = P.ws;
    const bf16* PQ = (const bf16*)(ws + WS_SG); const bf16* SK = (const bf16*)(ws + WS_SUBK); const float* SS2 = (const float*)(ws + WS_SS2);
    int* EI = MODE ? (int*)(ws + WS_UY + 32 * MiB) : (int*)(ws + WS_K); float* EG = MODE ? (float*)(ws + WS_UY + 48 * MiB) : (float*)(ws + WS_V);
    float* ES = (float*)(ws + WS_K + 16 * MiB); float* RSTD2 = (float*)(ws + WS_RSTD1 + 512 * 1024); const f32x2* UVQ = (const f32x2*)(ws + WS_UT + 4 * SLICE_BYTES);
    const int fr = lane & 15, fq = lane >> 4; const bool q0 = (fq & 1) != 0, q1 = (fq & 2) != 0;
    const float NEG = -__builtin_inff();
    constexpr int GI[4][13] = {{0,0,0,0,0,0,0,0,0,0,0,0,0}, {1,1,1,1,1,1,1,1,2,2,2,2,2}, {3,3,3,3,4,4,4,5,5,6,6,7,7}, {0,0,0,8,9,10,11,12,13,14,15,0,0}};
    constexpr int GJ[4][13] = {{0,1,2,3,4,5,6,7,8,9,10,11,12}, {0,1,2,3,4,5,6,7,0,1,2,3,4}, {0,1,2,3,0,1,2,0,1,0,1,0,1}, {13,14,15,0,0,0,0,0,0,0,0,0,0}};
    LAS unsigned char* sk = lds;
    LAS float* lut = (LAS float*)(lds + 2 * 128 * SKP + wave * 2048);
    if (MODE == 0) { float* SS3i = (float*)(ws + WS_UY + 16 * MiB);
        for (size_t i = (size_t)blockIdx.x * NTHR + threadIdx.x; i < (size_t)T * 4; i += (size_t)gridDim.x * NTHR) SS3i[i] = -1.0f; }
    for (int tile0 = blockIdx.x * NWAVES; tile0 < T / 16; tile0 += gridDim.x * NWAVES) {
        const int tile = tile0 + wave; const bool active = tile < T / 16; const int t = (active ? tile : 0) * 16 + fr;
        float rstd2;
        { const f32x4* sp = (const f32x4*)(SS2 + (size_t)t * 16); const f32x4 a = sp[0], b = sp[1], c = sp[2], d = sp[3];
          rstd2 = rsqrtf((((a[0] + a[1]) + (a[2] + a[3])) + ((b[0] + b[1]) + (b[2] + b[3])) + ((c[0] + c[1]) + (c[2] + c[3])) + ((d[0] + d[1]) + (d[2] + d[3]))) * (1.0f / D) + EPS); }
        if (MODE == 0 && active && fq == 0) RSTD2[t] = rstd2;
        u32x4 pid = {0u, 0u, 0u, 0u}; f32x4 pgate = {0.f, 0.f, 0.f, 0.f}; f32x2 psc[4] = {{0.f, 0.f}, {0.f, 0.f}, {0.f, 0.f}, {0.f, 0.f}};
#define P6_FLUSH(hh) do { if (active) { const size_t o_ = (size_t)t * 128 + (hh) * 16 + 4 * fq; *(u32x2*)((unsigned short*)EI + o_) = (u32x2){pid.x | (pid.y << 16), pid.z | (pid.w << 16)};     \
            u32x4 sg_; sg_.x = pk_h2(psc[0].x, pgate[0] * psc[0].y * 256.0f); sg_.y = pk_h2(psc[1].x, pgate[1] * psc[1].y * 256.0f); sg_.z = pk_h2(psc[2].x, pgate[2] * psc[2].y * 256.0f); sg_.w = pk_h2(psc[3].x, pgate[3] * psc[3].y * 256.0f); \
            *(u32x4*)(EG + o_) = sg_; } } while (0)
        u32x4 skr[8];
#pragma unroll
        for (int q = 0; q < 8; ++q) { const int i = threadIdx.x + q * NTHR; skr[q] = *(const u32x4*)(SK + ((size_t)(i >> 4)) * 128 + (i & 15) * 8); }
        bf16x8_t qn[4];
#pragma unroll
        for (int ks = 0; ks < 4; ++ks) qn[ks] = __builtin_nontemporal_load((const bf16x8_t*)(PQ + ((size_t)(t >> 4) * 64 + ks) * 512 + (fq * 16 + fr) * 8));
#pragma unroll 1
        for (int h = 0; h < 8; ++h) {
            __syncthreads();
#pragma unroll
            for (int q = 0; q < 8; ++q) { const int i = threadIdx.x + q * NTHR; *(LAS u32x4*)(sk + (i >> 4) * SKP + (i & 15) * 16) = skr[q]; }
            __syncthreads();
            { const int hn = h < 7 ? h + 1 : 7;
#pragma unroll
              for (int q = 0; q < 8; ++q) { const int i = threadIdx.x + q * NTHR; skr[q] = *(const u32x4*)(SK + ((size_t)hn * 256 + (i >> 4)) * 128 + (i & 15) * 8); } }
            if (MODE == 2) continue;
            float top[2][16];
#pragma unroll
            for (int p = 0; p < 2; ++p) {
                f32x4 acc[8];
#pragma unroll
                for (int nt = 0; nt < 8; ++nt) acc[nt] = (f32x4){0.f, 0.f, 0.f, 0.f};
#pragma unroll
                for (int ks = 0; ks < 4; ++ks) {
                    const bf16x8_t qf = qn[ks];
#pragma unroll
                    for (int nt = 0; nt < 8; ++nt) {
                        const bf16x8_t kf = *(const LAS bf16x8_t*)(sk + (p * 128 + nt * 16 + fr) * SKP + ks * 64 + fq * 16);
                        acc[nt] = __builtin_amdgcn_mfma_f32_16x16x32_bf16(kf, qf, acc[nt], 0, 0, 0); }
                }
                { const int nb = (h * 2 + p + 1) & 15;
#pragma unroll
                  for (int ks = 0; ks < 4; ++ks) qn[ks] = __builtin_nontemporal_load((const bf16x8_t*)(PQ + ((size_t)(t >> 4) * 64 + nb * 4 + ks) * 512 + (fq * 16 + fr) * 8)); }
                if (MODE == 0 && p == 0 && h > 0) P6_FLUSH(h - 1);
                float a[16], b[16];
#pragma unroll
                for (int nt = 0; nt < 4; ++nt)
#pragma unroll
                    for (int r = 0; r < 4; ++r) { a[nt * 4 + r] = pk_idx(acc[nt][r], (unsigned)(nt * 16 + 4 * fq + r)); b[nt * 4 + r] = pk_idx(acc[nt + 4][r], (unsigned)((nt + 4) * 16 + 4 * fq + r)); }
                if (MODE == 1) { float keep = 0.f;
#pragma unroll
                    for (int i = 0; i < 16; ++i) keep += a[i] + b[i];
#pragma unroll
                    for (int i = 0; i < 16; ++i) top[p][i] = keep; continue; }
                bitonic_sort16(a); bitonic_sort16(b);
#pragma unroll
                for (int i = 0; i < 16; ++i) a[i] = fmaxf(a[i], b[15 - i]);
                bitonic_merge16(a);
                xlane_top16(a, 16); xlane_top16(a, 32);
#pragma unroll
                for (int i = 0; i < 16; ++i) top[p][i] = a[i];
            }
            if (MODE == 1) { if (active && fq == 0) EG[(size_t)t * 128 + h] = top[0][0] + top[1][0]; continue; }
            { f32x4 w0, w1;
#pragma unroll
              for (int r = 0; r < 4; ++r) { w0[r] = sel4f(q0, q1, top[0][r], top[0][4 + r], top[0][8 + r], top[0][12 + r]);
                                            w1[r] = sel4f(q0, q1, top[1][r], top[1][4 + r], top[1][8 + r], top[1][12 + r]); }
              *(LAS f32x4*)(lut + fr * 32 + 4 * fq) = w0; *(LAS f32x4*)(lut + fr * 32 + 16 + 4 * fq) = w1; }
            float cv[16];
#pragma unroll
            for (int sl = 0; sl < 13; ++sl) {
                const float av = sel4f(q0, q1, top[0][GI[0][sl]], top[0][GI[1][sl]], top[0][GI[2][sl]], top[0][GI[3][sl]]);
                const float bv = sel4f(q0, q1, top[1][GJ[0][sl]], top[1][GJ[1][sl]], top[1][GJ[2][sl]], top[1][GJ[3][sl]]);
                const unsigned code = sel4u(q0, q1, (unsigned)(GI[0][sl] * 16 + GJ[0][sl]), (unsigned)(GI[1][sl] * 16 + GJ[1][sl]), (unsigned)(GI[2][sl] * 16 + GJ[2][sl]), (unsigned)(GI[3][sl] * 16 + GJ[3][sl]));
                const float sm = __uint_as_float(__float_as_uint(av) & ~127u) + __uint_as_float(__float_as_uint(bv) & ~127u);
                const bool pad = (sl >= 11) && (fq == 3);
                cv[sl] = pad ? NEG : __uint_as_float((__float_as_uint(sm) & ~255u) | code);
            }
            cv[13] = NEG; cv[14] = NEG; cv[15] = NEG;
            bitonic_sort16(cv);
            xlane_top16(cv, 16); xlane_top16(cv, 32);
            float wv[4];
#pragma unroll
            for (int r = 0; r < 4; ++r) wv[r] = sel4f(q0, q1, cv[r], cv[4 + r], cv[8 + r], cv[12 + r]);
            LDS_WAIT();
            const float sc2 = rstd2 * 1.4426950408889634f; const float wmax = __uint_as_float(__float_as_uint(cv[0]) & ~255u);
            u32x4 ids; f32x4 ex; float part = 0.f;
#pragma unroll
            for (int r = 0; r < 4; ++r) { const unsigned bits = __float_as_uint(wv[r]); const unsigned ci = (bits >> 4) & 15u, cj = bits & 15u;
                const unsigned ia = __float_as_uint(lut[fr * 32 + ci]) & 127u, ib = __float_as_uint(lut[fr * 32 + 16 + cj]) & 127u;
                ids[r] = (ia << 7) | ib;
                ex[r] = __builtin_amdgcn_exp2f((__uint_as_float(bits & ~255u) - wmax) * sc2); part += ex[r]; }
            part += __shfl_xor(part, 16); part += __shfl_xor(part, 32);
            const float inv = 1.0f / part;
            pid = ids; pgate = ex * inv;
#pragma unroll
            for (int r = 0; r < 4; ++r) psc[r] = UVQ[ids[r]];
            LDS_WAIT();
        }
        if (MODE == 0) P6_FLUSH(7);
#undef P6_FLUSH
    }
}

__device__ __forceinline__ float dot2bf(unsigned a, unsigned b, float acc) {
    return __builtin_amdgcn_fdot2_f32_bf16(__builtin_bit_cast(bf16x2_t, a), __builtin_bit_cast(bf16x2_t, b), acc, false);
}
__device__ __forceinline__ float dot8(const u32x4& a, const u32x4& b, float acc) {
    const unsigned a0 = a.x, a1 = a.y, a2 = a.z, a3 = a.w, b0 = b.x, b1 = b.y, b2 = b.z, b3 = b.w;
    acc = dot2bf(a0, b0, acc); acc = dot2bf(a1, b1, acc); acc = dot2bf(a2, b2, acc); acc = dot2bf(a3, b3, acc);
    return acc;
}
__device__ __forceinline__ void axpy8(float (&o)[8], float a, const u32x4& v) {
    o[0] = fmaf(a, bflo(v.x), o[0]); o[1] = fmaf(a, bfhi(v.x), o[1]); o[2] = fmaf(a, bflo(v.y), o[2]); o[3] = fmaf(a, bfhi(v.y), o[3]);
    o[4] = fmaf(a, bflo(v.z), o[4]); o[5] = fmaf(a, bfhi(v.z), o[5]); o[6] = fmaf(a, bflo(v.w), o[6]); o[7] = fmaf(a, bfhi(v.w), o[7]);
}
__device__ __forceinline__ void fp8_dot16(const u32x4& w, const f32x2 (&h)[8], f32x2& acc0, f32x2& acc1) {
    const unsigned w0 = w.x, w1 = w.y, w2 = w.z, w3 = w.w;
    acc0 = __builtin_elementwise_fma(__builtin_amdgcn_cvt_pk_f32_fp8(w0, false), h[0], acc0); acc1 = __builtin_elementwise_fma(__builtin_amdgcn_cvt_pk_f32_fp8(w0, true), h[1], acc1);
    acc0 = __builtin_elementwise_fma(__builtin_amdgcn_cvt_pk_f32_fp8(w1, false), h[2], acc0); acc1 = __builtin_elementwise_fma(__builtin_amdgcn_cvt_pk_f32_fp8(w1, true), h[3], acc1);
    acc0 = __builtin_elementwise_fma(__builtin_amdgcn_cvt_pk_f32_fp8(w2, false), h[4], acc0); acc1 = __builtin_elementwise_fma(__builtin_amdgcn_cvt_pk_f32_fp8(w2, true), h[5], acc1);
    acc0 = __builtin_elementwise_fma(__builtin_amdgcn_cvt_pk_f32_fp8(w3, false), h[6], acc0); acc1 = __builtin_elementwise_fma(__builtin_amdgcn_cvt_pk_f32_fp8(w3, true), h[7], acc1);
}
__device__ __forceinline__ void fp8_axpy16(const u32x4& w, float a, f32x2 (&o)[8]) {
    const unsigned w0 = w.x, w1 = w.y, w2 = w.z, w3 = w.w; const f32x2 aa = {a, a};
    o[0] = __builtin_elementwise_fma(__builtin_amdgcn_cvt_pk_f32_fp8(w0, false), aa, o[0]); o[1] = __builtin_elementwise_fma(__builtin_amdgcn_cvt_pk_f32_fp8(w0, true), aa, o[1]);
    o[2] = __builtin_elementwise_fma(__builtin_amdgcn_cvt_pk_f32_fp8(w1, false), aa, o[2]); o[3] = __builtin_elementwise_fma(__builtin_amdgcn_cvt_pk_f32_fp8(w1, true), aa, o[3]);
    o[4] = __builtin_elementwise_fma(__builtin_amdgcn_cvt_pk_f32_fp8(w2, false), aa, o[4]); o[5] = __builtin_elementwise_fma(__builtin_amdgcn_cvt_pk_f32_fp8(w2, true), aa, o[5]);
    o[6] = __builtin_elementwise_fma(__builtin_amdgcn_cvt_pk_f32_fp8(w3, false), aa, o[6]); o[7] = __builtin_elementwise_fma(__builtin_amdgcn_cvt_pk_f32_fp8(w3, true), aa, o[7]);
}
__device__ __forceinline__ float lx1(float v) { return __uint_as_float(__builtin_amdgcn_update_dpp(0u, __float_as_uint(v), 0xB1, 0xf, 0xf, false)); }
__device__ __forceinline__ float lx2(float v) { return __uint_as_float(__builtin_amdgcn_update_dpp(0u, __float_as_uint(v), 0x4E, 0xf, 0xf, false)); }
__device__ __forceinline__ float lx4(float v) { const unsigned a = __builtin_amdgcn_update_dpp(0u, __float_as_uint(v), 0x104, 0xf, 0x5, false);
                                                 return __uint_as_float(__builtin_amdgcn_update_dpp(a, __float_as_uint(v), 0x114, 0xf, 0xA, false)); }
template <int N>
__device__ __forceinline__ void group8_reduce(float* p, int lane) {
    { const bool up = (lane & 4) != 0;
#pragma unroll
      for (int i = 0; i < N / 2; ++i) { const float send = up ? p[i] : p[i + N / 2], keep = up ? p[i + N / 2] : p[i]; p[i] = keep + lx4(send); } }
    { const bool up = (lane & 2) != 0;
#pragma unroll
      for (int i = 0; i < N / 4; ++i) { const float send = up ? p[i] : p[i + N / 4], keep = up ? p[i + N / 4] : p[i]; p[i] = keep + lx2(send); } }
    { const bool up = (lane & 1) != 0;
#pragma unroll
      for (int i = 0; i < N / 8; ++i) { const float send = up ? p[i] : p[i + N / 8], keep = up ? p[i + N / 8] : p[i]; p[i] = keep + lx1(send); } }
}
constexpr float H_SCALE = 16.0f;
__device__ __forceinline__ int q8(float v) { int q = (int)rintf(v * H_SCALE); return q < -127 ? -127 : (q > 127 ? 127 : q); }
__device__ __forceinline__ void p7a_upass(const Params& P, LAS unsigned char* lds, int wave, int lane) {
    unsigned char* ws = P.ws;
    const unsigned char* X1I = ws + WS_X1I8; const int* EI = (const int*)(ws + WS_K);
    const int x = blockIdx.x & 3, half = (blockIdx.x >> 2) & 1, rank = blockIdx.x >> 3, nloc = gridDim.x >> 3, p8 = lane >> 3, c = lane & 7;
    const unsigned char* Us = ws + WS_UT + (size_t)x * SLICE_BYTES + c * 16;
    float* AP = (float*)((unsigned short*)(ws + WS_SG) + (size_t)x * T * 128);
    const int ntok = (T / 2) / (nloc * NWAVES);
#define TOKU(n) (half * (T / 2) + (((n) * nloc + rank) * NWAVES) + wave)
#define U_META(Ev, Hv, t_) do { const u32x4* ep_ = (const u32x4*)((const unsigned short*)EI + (size_t)(t_) * 128 + 16 * p8); Ev[0] = ep_[0]; Ev[1] = ep_[1]; \
        const u32x4* hp_ = (const u32x4*)(X1I + (size_t)(t_) * D + 256 * x + 32 * c); Hv[0] = __builtin_nontemporal_load(hp_); Hv[1] = __builtin_nontemporal_load(hp_ + 1); } while (0)
#define U_ROW(e_) (*(const u32x4*)(Us + (size_t)(e_) * 128))
#define U_ISSUE(R, Ev, q0) do { const u32x4 e_ = Ev[(q0) >> 1];     \
        R[0] = U_ROW(e_.x & 0xffffu); R[1] = U_ROW(e_.x >> 16); R[2] = U_ROW(e_.y & 0xffffu); R[3] = U_ROW(e_.y >> 16); R[4] = U_ROW(e_.z & 0xffffu); R[5] = U_ROW(e_.z >> 16); R[6] = U_ROW(e_.w & 0xffffu); R[7] = U_ROW(e_.w >> 16); } while (0)
#define TOKUC(n_) TOKU((n_) < ntok ? (n_) : ntok - 1)
#define U_DOT(Rv, dst) do { int acc_ = 0; const unsigned w0_ = Rv.x, w1_ = Rv.y, w2_ = Rv.z, w3_ = Rv.w; \
            acc_ = __builtin_amdgcn_sdot4((int)(w0_ & 0x0F0F0F0Fu), he[0], acc_, false); acc_ = __builtin_amdgcn_sdot4((int)((w0_ >> 4) & 0x0F0F0F0Fu), ho[0], acc_, false); \
            acc_ = __builtin_amdgcn_sdot4((int)(w1_ & 0x0F0F0F0Fu), he[1], acc_, false); acc_ = __builtin_amdgcn_sdot4((int)((w1_ >> 4) & 0x0F0F0F0Fu), ho[1], acc_, false); \
            acc_ = __builtin_amdgcn_sdot4((int)(w2_ & 0x0F0F0F0Fu), he[2], acc_, false); acc_ = __builtin_amdgcn_sdot4((int)((w2_ >> 4) & 0x0F0F0F0Fu), ho[2], acc_, false); \
            acc_ = __builtin_amdgcn_sdot4((int)(w3_ & 0x0F0F0F0Fu), he[3], acc_, false); acc_ = __builtin_amdgcn_sdot4((int)((w3_ >> 4) & 0x0F0F0F0Fu), ho[3], acc_, false); \
            dst = (float)acc_ + corr; } while (0)
#define U_STEP(BP, BQ, EV, HV, n_) do { const int t = TOKU(n_); \
        const int he[4] = {(int)HV[0].x, (int)HV[0].z, (int)HV[1].x, (int)HV[1].z}, ho[4] = {(int)HV[0].y, (int)HV[0].w, (int)HV[1].y, (int)HV[1].w}; \
        int hs = 0; \
        _Pragma("unroll") for (int w = 0; w < 4; ++w) { hs = __builtin_amdgcn_sdot4(he[w], 0x01010101, hs, false); hs = __builtin_amdgcn_sdot4(ho[w], 0x01010101, hs, false); } \
        const float corr = -7.5f * (float)hs; \
        float p[16]; \
        _Pragma("unroll") for (int i = 0; i < 8; ++i) U_DOT(BP[i], p[i]); \
        U_ISSUE(BP, EV, 0); \
        _Pragma("unroll") for (int i = 0; i < 8; ++i) U_DOT(BQ[i], p[8 + i]); \
        U_ISSUE(BQ, EV, 2); \
        group8_reduce<16>(p, lane); \
        { typedef _Float16 h2_t __attribute__((ext_vector_type(2))); const h2_t hp_ = {(_Float16)(p[0] * (1.0f / 16.0f)), (_Float16)(p[1] * (1.0f / 16.0f))};     \
          *(unsigned*)((unsigned short*)AP + (size_t)t * 128 + 2 * lane) = __builtin_bit_cast(unsigned, hp_); } \
        { const u32x4* ep_ = (const u32x4*)((const unsigned short*)EI + (size_t)TOKUC((n_) + 4) * 128 + 16 * p8); EV[0] = ep_[0]; EV[1] = ep_[1]; \
          const u32x4* hp_ = (const u32x4*)(X1I + (size_t)TOKUC((n_) + 2) * D + 256 * x + 32 * c); HV[0] = __builtin_nontemporal_load(hp_); HV[1] = __builtin_nontemporal_load(hp_ + 1); } } while (0)
    u32x4 eiA[2], eiB[2], hA[2], hB[2], bufP[8], bufQ[8], bufR[8], bufS[8];
#define U_EIX(Ev, Hv, ne_, nh_) do { const u32x4* ep_ = (const u32x4*)((const unsigned short*)EI + (size_t)TOKUC(ne_) * 128 + 16 * p8); Ev[0] = ep_[0]; Ev[1] = ep_[1]; \
        const u32x4* hp_ = (const u32x4*)(X1I + (size_t)TOKUC(nh_) * D + 256 * x + 32 * c); Hv[0] = __builtin_nontemporal_load(hp_); Hv[1] = __builtin_nontemporal_load(hp_ + 1); } while (0)
    { u32x4 e0[2], e1[2];
      { const u32x4* ep_ = (const u32x4*)((const unsigned short*)EI + (size_t)TOKU(0) * 128 + 16 * p8); e0[0] = ep_[0]; e0[1] = ep_[1]; }
      { const u32x4* ep_ = (const u32x4*)((const unsigned short*)EI + (size_t)TOKUC(1) * 128 + 16 * p8); e1[0] = ep_[0]; e1[1] = ep_[1]; }
      U_ISSUE(bufP, e0, 0); U_ISSUE(bufQ, e0, 2); asm volatile("" ::: "memory"); U_EIX(eiA, hA, 2, 0); asm volatile("" ::: "memory");
      U_ISSUE(bufR, e1, 0); U_ISSUE(bufS, e1, 2); asm volatile("" ::: "memory"); U_EIX(eiB, hB, 3, 1); asm volatile("" ::: "memory"); }
#undef U_EIX
#pragma unroll 1
    for (int n = 0; n < ntok; n += 2) {
        U_STEP(bufP, bufQ, eiA, hA, n);
        U_STEP(bufR, bufS, eiB, hB, n + 1);
    }
#undef U_STEP
#undef TOKUC
#undef TOKU
#undef U_META
#undef U_ROW
#undef U_ISSUE
#undef U_DOT
}
typedef int v2i_t __attribute__((ext_vector_type(2)));
typedef int v8i_t __attribute__((ext_vector_type(8)));
typedef _Float16 h2v_t __attribute__((ext_vector_type(2)));
__device__ __forceinline__ f32x2 h2_to_f2(unsigned w) { const h2v_t h = __builtin_bit_cast(h2v_t, w); const _Float16 a = h[0], b = h[1]; return (f32x2){(float)a, (float)b}; }
__device__ __forceinline__ void p7c_vpass_mfma(const Params& P, LAS unsigned char* lds, int wave, int lane) {
    unsigned char* ws = P.ws;
    const int* EI = (const int*)(ws + WS_K); const float* AP = (const float*)(ws + WS_SG); const float* EG = (const float*)(ws + WS_V); const float* ES = (const float*)(ws + WS_K + 16 * MiB);
    const float* RSTD2 = (const float*)(ws + WS_RSTD1 + 512 * 1024);
    LAS unsigned char* img = lds + wave * 16384;
    LAS unsigned char* actl = lds + LDS_MISC + wave * 512;
    LAS float* outl = (LAS float*)(lds + LDS_MISC + 4096 + wave * 1024);
    float* SS3 = (float*)(ws + WS_UY + 16 * MiB);
    const int x = blockIdx.x & 3, half = (blockIdx.x >> 2) & 1, rank = blockIdx.x >> 3, nloc = gridDim.x >> 3, p8 = lane >> 3, c = lane & 7, kq = lane >> 4, j16 = lane & 15;
    const unsigned char* Vs = ws + WS_VT + (size_t)x * SLICE_BYTES;
    bf16* X1B = (bf16*)(ws + WS_Q);
    const int ntok = (T / 2) / (nloc * NWAVES);
    const bool swp = (__builtin_amdgcn_cvt_scalef32_pk_fp4_f32(0u, 0.5f, 1.0f, 1.0f, 0) & 0xffu) != 0x21u;
    const unsigned coffe = (unsigned)((c ^ (p8 >> 1)) << 4), coffo = (unsigned)((c ^ (4 + (p8 >> 1))) << 4);
    LAS unsigned char* trb = img + (32 * kq + j16) * 128; const int f0 = (j16 >> 1) & 7;
#define TOK(n) (half * (T / 2) + (((n) * nloc + rank) * NWAVES) + wave)
#define V_META(EIv, t_) do { const u32x4* ep_ = (const u32x4*)((const unsigned short*)EI + (size_t)(t_) * 128 + 16 * p8); EIv[0] = __builtin_nontemporal_load(ep_); EIv[1] = __builtin_nontemporal_load(ep_ + 1); } while (0)
#define V_H2(w_) h2_to_f2(w_)
#define V_RAW(R, t_) do { const size_t o_ = (size_t)(t_) * 128 + 2 * lane; const unsigned short* ah_ = (const unsigned short*)AP; \
        const unsigned w0_ = __builtin_nontemporal_load((const unsigned*)(ah_ + o_)), w1_ = __builtin_nontemporal_load((const unsigned*)(ah_ + (size_t)T * 128 + o_)), \
                       w2_ = __builtin_nontemporal_load((const unsigned*)(ah_ + (size_t)2 * T * 128 + o_)), w3_ = __builtin_nontemporal_load((const unsigned*)(ah_ + (size_t)3 * T * 128 + o_)); \
        R[4] = __builtin_nontemporal_load((const f32x2*)(EG + o_)); R[5] = (f32x2){0.f, 0.f}; R[6] = (f32x2){RSTD2[t_], 0.f};     \
        R[0] = __builtin_bit_cast(f32x2, (u32x2){w0_, w1_}); R[1] = __builtin_bit_cast(f32x2, (u32x2){w2_, w3_}); R[2] = (f32x2){0.f, 0.f}; R[3] = (f32x2){0.f, 0.f}; } while (0)
#define V_DMA(EIv) do { _Pragma("unroll") for (int q = 0; q < 16; ++q) { const unsigned w_ = ((q >> 1) & 3) == 0 ? EIv[q >> 3].x : ((q >> 1) & 3) == 1 ? EIv[q >> 3].y : ((q >> 1) & 3) == 2 ? EIv[q >> 3].z : EIv[q >> 3].w; const unsigned e_ = (q & 1) ? (w_ >> 16) : (w_ & 0xffffu); \
        __builtin_amdgcn_global_load_lds((const unsigned*)(Vs + (size_t)e_ * 128 + ((q & 1) ? coffo : coffe)), (LAS unsigned*)(img + q * 1024), 16, 0, 0); } } while (0)
#define V_ACTA(Aop, Ainv, R) do { const u32x2 pk0_ = __builtin_bit_cast(u32x2, R[0]), pk1_ = __builtin_bit_cast(u32x2, R[1]); \
        const f32x2 a_ = (V_H2(pk0_.x) + V_H2(pk0_.y)) + (V_H2(pk1_.x) + V_H2(pk1_.y)); const float asc_ = R[6].x * (16.0f / H_SCALE);     \
        const u32x2 sgw_ = __builtin_bit_cast(u32x2, R[4]); const f32x2 sg0_ = V_H2(sgw_.x), sg1_ = V_H2(sgw_.y);     \
        f32x2 act_ = pg8::gelu_pk((f32x2){a_.x * sg0_.x * asc_, a_.y * sg1_.x * asc_}) * (f32x2){sg0_.y * (1.0f / 256.0f), sg1_.y * (1.0f / 256.0f)};     \
        const float amax_ = wave_max(fmaxf(fabsf(act_.x), fabsf(act_.y))); const int ex_ = 7 - __builtin_amdgcn_frexp_expf(fmaxf(amax_, 1e-30f)); \
        const float sc_ = __builtin_amdgcn_ldexpf(1.0f, ex_); Ainv = __builtin_amdgcn_ldexpf(1.0f, -ex_); act_ *= sc_; \
        LDS_WAIT(); *(LAS f32x2*)(actl + lane * 8) = act_; LDS_WAIT(); \
        f32x4 va_[8]; _Pragma("unroll") for (int a = 0; a < 8; ++a) { const f32x2 lo2_ = *(const LAS f32x2*)(actl + (16 * a + 2 * kq) * 4), hi2_ = *(const LAS f32x2*)(actl + (16 * a + 8 + 2 * kq) * 4); va_[a] = (f32x4){lo2_.x, lo2_.y, hi2_.x, hi2_.y}; } \
        LDS_WAIT(); \
          \
        _Pragma("unroll") for (int w = 0; w < 8; ++w) { const int b_ = 2 * (w >> 2) + ((w >> 1) & 1), a0_ = 4 * (w & 1); \
            const float v0_ = va_[a0_][b_], v1_ = va_[a0_ + 1][b_], v2_ = va_[a0_ + 2][b_], v3_ = va_[a0_ + 3][b_]; \
            unsigned hi_ = __builtin_amdgcn_cvt_pk_fp8_f32(v0_, v1_, 0u, false); hi_ = __builtin_amdgcn_cvt_pk_fp8_f32(v2_, v3_, hi_, true); \
            const f32x2 d0_ = __builtin_amdgcn_cvt_pk_f32_fp8(hi_, false), d1_ = __builtin_amdgcn_cvt_pk_f32_fp8(hi_, true); \
            unsigned lo_ = __builtin_amdgcn_cvt_pk_fp8_f32(v0_ - d0_.x, v1_ - d0_.y, 0u, false); lo_ = __builtin_amdgcn_cvt_pk_fp8_f32(v2_ - d1_.x, v3_ - d1_.y, lo_, true); \
            Aop[w] = (int)(j16 == 0 ? hi_ : (j16 == 1 ? lo_ : 0u)); } } while (0)
    const f32x4 gfin = *(const f32x4*)(P.g_fin + 256 * x + 4 * lane);
    f32x4 yA = {0.f, 0.f, 0.f, 0.f}, yB = yA, yC = yA, yD = yA, yE = yA, yF = yA; float pss[4] = {0.f, 0.f, 0.f, 0.f}; float ssPrev = 0.f;
#define V_SSLD(Pv, t_) do { _Pragma("unroll") for (int k_ = 0; k_ < 4; ++k_) Pv[k_] = __hip_atomic_load(SS3 + (size_t)(t_) * 4 + k_, __ATOMIC_RELAXED, __HIP_MEMORY_SCOPE_SYSTEM); } while (0)
#define V_FIN(Pv, t_, Yv) do { unsigned sp_ = 0; while (fminf(fminf(Pv[0], Pv[1]), fminf(Pv[2], Pv[3])) < 0.f && ++sp_ < (1u << 20)) { __builtin_amdgcn_s_sleep(8); V_SSLD(Pv, t_); } \
        const float r_ = rsqrtf(((Pv[0] + Pv[1]) + (Pv[2] + Pv[3])) * (1.0f / D) + EPS); \
        __builtin_nontemporal_store((f32x4){Yv[0] * r_ * gfin[0], Yv[1] * r_ * gfin[1], Yv[2] * r_ * gfin[2], Yv[3] * r_ * gfin[3]}, (f32x4*)(P.out + (size_t)(t_) * D + 256 * x + 4 * lane)); } while (0)
#define TOKC(n_) TOK((n_) < 0 ? 0 : ((n_) < ntok ? (n_) : ntok - 1))
    u32x4 eiB[2], eiU[2]; f32x2 rawC[7]; v8i_t aA, aB, aC; float invA, invB, invC; u32x2 x1w;
    V_META(eiU, TOK(0)); V_RAW(rawC, TOK(0));
    V_DMA(eiU);
    V_ACTA(aA, invA, rawC); V_RAW(rawC, TOKC(1));
    V_ACTA(aB, invB, rawC); V_RAW(rawC, TOKC(2));
    V_META(eiB, TOKC(1));
    x1w = __builtin_nontemporal_load((const u32x2*)(X1B + (size_t)TOK(0) * D + 256 * x + 4 * lane));
#pragma unroll 1
    for (int n = 0; n < ntok; ++n) {
        const int t = TOK(n);
        asm volatile("s_waitcnt vmcnt(0)" ::: "memory");
        float xb0 = bflo(x1w.x), xb1 = bfhi(x1w.x), xb2 = bflo(x1w.y), xb3 = bfhi(x1w.y);
        asm volatile("" : "+v"(xb0), "+v"(xb1), "+v"(xb2), "+v"(xb3));
        f32x2 rawU[7]; float pssU[4];
#pragma unroll
        for (int i = 0; i < 4; ++i) { if (i < 2) { eiU[i] = eiB[i]; asm volatile("" : "+v"(eiU[i])); } pssU[i] = pss[i]; asm volatile("" : "+v"(pssU[i])); }
#pragma unroll
        for (int i = 0; i < 7; ++i) { rawU[i] = rawC[i]; asm volatile("" : "+v"(rawU[i])); }
        if (n >= 1 && lane == 0) __hip_atomic_store(SS3 + (size_t)TOK(n - 1) * 4 + x, ssPrev, __ATOMIC_RELAXED, __HIP_MEMORY_SCOPE_SYSTEM);
        x1w = __builtin_nontemporal_load((const u32x2*)(X1B + (size_t)TOKC(n + 1) * D + 256 * x + 4 * lane));
        V_META(eiB, TOKC(n + 2)); V_RAW(rawC, TOKC(n + 3)); V_SSLD(pss, TOKC(n - 5));
        asm volatile("" ::: "memory");
        if (n >= 6) V_FIN(pssU, TOK(n - 6), yF);
        V_ACTA(aC, invC, rawU);
        f32x4 acc[16];
#pragma unroll
        for (int nb = 0; nb < 16; ++nb) {
            const int off = (((nb >> 1) ^ f0) << 4) | ((nb & 1) << 3);
            const v2i_t t0 = __builtin_amdgcn_ds_read_tr4_b64_v2i32((LAS v2i_t*)(trb + off)), t1 = __builtin_amdgcn_ds_read_tr4_b64_v2i32((LAS v2i_t*)(trb + 2048 + off));
            const v8i_t bop = {t0.x, t0.y, t1.x, t1.y, 0, 0, 0, 0};
            acc[nb] = __builtin_amdgcn_mfma_scale_f32_16x16x128_f8f6f4(aA, bop, (f32x4){0.f, 0.f, 0.f, 0.f}, 0, 4, 0, 0x7f7f7f7f, 0, 0x7f7f7f7f);
        }
        LDS_WAIT();
        asm volatile("" ::: "memory");
        V_DMA(eiU);
        if (lane < 16) {
#pragma unroll
            for (int nb = 0; nb < 16; ++nb) outl[16 * nb + lane] = acc[nb][0] + acc[nb][1]; }
        LDS_WAIT();
        f32x4 v = *(const LAS f32x4*)(outl + 4 * lane);
        LDS_WAIT();
        if (swp) v = (f32x4){v[1], v[0], v[3], v[2]};
        const float y0 = xb0 + v[0] * invA, y1 = xb1 + v[1] * invA, y2 = xb2 + v[2] * invA, y3 = xb3 + v[3] * invA;
        const float ss = wave_sum((y0 * y0 + y1 * y1) + (y2 * y2 + y3 * y3));
        ssPrev = ss;
        yF = yE; yE = yD; yD = yC; yC = yB; yB = yA; yA = (f32x4){y0, y1, y2, y3};
        aA = aB; invA = invB; aB = aC; invB = invC;
    }
    if (lane == 0) __hip_atomic_store(SS3 + (size_t)TOK(ntok - 1) * 4 + x, ssPrev, __ATOMIC_RELAXED, __HIP_MEMORY_SCOPE_SYSTEM);
    asm volatile("s_waitcnt vmcnt(0)" ::: "memory");
    { float p5[4], p4[4], p3[4], p2[4], p1[4]; V_SSLD(p5, TOK(ntok - 5)); V_SSLD(p4, TOK(ntok - 4)); V_SSLD(p3, TOK(ntok - 3)); V_SSLD(p2, TOK(ntok - 2)); V_SSLD(p1, TOK(ntok - 1));
      V_FIN(pss, TOK(ntok - 6), yF); V_FIN(p5, TOK(ntok - 5), yE); V_FIN(p4, TOK(ntok - 4), yD); V_FIN(p3, TOK(ntok - 3), yC); V_FIN(p2, TOK(ntok - 2), yB); V_FIN(p1, TOK(ntok - 1), yA); }
#undef TOKC
#undef V_SSLD
#undef V_FIN
#undef V_META
#undef V_RAW
#undef V_DMA
#undef V_ACTA
#undef TOK
}
__global__ void __launch_bounds__(NTHR, 2) fwd_mega(Params P) {
    extern __shared__ __attribute__((aligned(16))) unsigned char lds_raw[];
    LAS unsigned char* lds = (LAS unsigned char*)lds_raw;
    const int tid = threadIdx.x, lane = tid & 63, wave = __builtin_amdgcn_readfirstlane(tid >> 6);
    unsigned char* ws = P.ws;
    const int G = gridDim.x, c = blockIdx.x;
    volatile LAS unsigned* bst = (volatile LAS unsigned*)(lds + LDS_MISC + 16000);
    if (tid < 4) bst[tid] = 0u;
    __syncthreads();
    XcdBarrier bar = xcd_barrier_post((unsigned*)(ws + WS_CTL), bst);

#ifndef PH_MASK
#define PH_MASK 0x7FF
#endif
#define IN(k) ((((PH_MASK) >> (k)) & 1) && P.lo <= (k) && (k) < P.hi)
#define SEAM(k) do { if (IN(k) && IN((k) + 1)) xcd_barrier(bar); } while (0)
#ifndef REP0
#define REP0 1
#endif
#ifndef REP1
#define REP1 1
#endif
#ifndef REP2
#define REP2 1
#endif
#ifndef REP3
#define REP3 1
#endif
#ifndef REP4
#define REP4 1
#endif
#ifndef REP5
#define REP5 1
#endif
#ifndef REP6
#define REP6 1
#endif
    if (IN(0)) for (int rep = 0; rep < REP0; ++rep) p0_prologue(P, lds, wave, lane);
    SEAM(0);
    if (IN(1)) for (int rep = 0; rep < REP1; ++rep) {
        pg8::Gemm g{(const pg8::bf16_t*)P.out, (const pg8::bf16_t*)(ws + WS_WIN), T, INW, D};
        pg8::StaticOrder S; S.init(T, INW, G, c);
        pg8::EpiProj E{(pg8::bf16_t*)(ws + WS_UY), (pg8::bf16_t*)(ws + WS_GV), (pg8::bf16_t*)(ws + WS_Q), (pg8::bf16_t*)(ws + WS_K), (pg8::bf16_t*)(ws + WS_V), (pg8::bf16_t*)(ws + WS_SG),
                       (const float*)(ws + WS_RSTD1), (float*)(ws + WS_SS)};
        pg8::gemm_phase<pg8::EpiProj, pg8::StaticOrder, true, true>(lds, g, S, E);
    }
    SEAM(1);
    if (IN(2)) { p2_sgu_mfma(P, lds, wave, lane);
    __syncthreads();
    for (int rep = 0; rep < REP2; ++rep) p2_attn_mfma(P, lds, wave, lane); }
    SEAM(2);
    if (IN(3)) for (int rep = 0; rep < REP3; ++rep) {
        pg8::StaticOrder S; S.init(T, 1024, G, c);
        pg8::Gemm g{(const pg8::bf16_t*)(ws + WS_UY), (const pg8::bf16_t*)(ws + WS_WA), T, 1024, 1536};
        pg8::EpiMergeFused E{(const pg8::bf16_t*)(ws + WS_SG), (pg8::bf16_t*)(ws + WS_GV)};
        pg8::gemm_phase<pg8::EpiMergeFused, pg8::StaticOrder, true, true>(lds, g, S, E);
    }
    SEAM(3);
    if (IN(4)) for (int rep = 0; rep < REP4; ++rep) {
        pg8::StaticOrder S; S.init(T, 1024, G, c);
        pg8::Gemm g{(const pg8::bf16_t*)(ws + WS_GV), (const pg8::bf16_t*)(ws + WS_WO), T, 1024, 1024};
        pg8::EpiX1 E{(const pg8::bf16_t*)P.out, (pg8::bf16_t*)(ws + WS_Q), (float*)(ws + WS_SS2), ws + WS_X1I8};
        pg8::gemm_phase<pg8::EpiX1, pg8::StaticOrder, true, true>(lds, g, S, E);
    }
    SEAM(4);
    if (IN(5)) for (int rep = 0; rep < REP5; ++rep) {
        pg8::StaticOrder S; S.init(T, 2048, G, c);
        pg8::Gemm g{(const pg8::bf16_t*)(ws + WS_Q), (const pg8::bf16_t*)(ws + WS_WQ), T, 2048, 1024};
        pg8::EpiBlk E{(pg8::bf16_t*)(ws + WS_SG), 2048};
        pg8::gemm_phase<pg8::EpiBlk, pg8::StaticOrder, true, true>(lds, g, S, E);
    }
    SEAM(5);
    if (IN(6)) for (int rep = 0; rep < REP6; ++rep) p6_topk_mfma<0>(P, lds, wave, lane);
    SEAM(6);
#ifndef REP7A
#define REP7A 1
#endif
    if (IN(7)) for (int rep = 0; rep < REP7A; ++rep) p7a_upass(P, lds, wave, lane);
    if (IN(7) && IN(9)) xcd_barrier(bar);
#ifndef REP9
#define REP9 1
#endif
    if (IN(9)) for (int rep = 0; rep < REP9; ++rep) p7c_vpass_mfma(P, lds, wave, lane);
}

extern "C" void kernel_launch(void* const* d_in, const int* in_sizes, int n_in, void* d_out, int out_size, void* d_ws, size_t ws_size, hipStream_t stream) {
    static int grid = 0;
    if (grid == 0) {
        if (n_in != 15 || out_size != T * D || ws_size < WS_END) { fprintf(stderr, "kernel_launch: unexpected shapes/workspace (n_in %d out %d ws %zu)\n", n_in, out_size, ws_size); grid = -1; return; }
        int dev = 0, cus = 0, per_cu = 0;
        hipGetDevice(&dev); hipDeviceGetAttribute(&cus, hipDeviceAttributeMultiprocessorCount, dev);
        hipFuncSetAttribute((const void*)fwd_mega, hipFuncAttributeMaxDynamicSharedMemorySize, LDS_BYTES);
        hipOccupancyMaxActiveBlocksPerMultiprocessor(&per_cu, (const void*)fwd_mega, NTHR, LDS_BYTES);
        if (per_cu < 1) { fprintf(stderr, "kernel_launch: occupancy query says %d blocks per CU\n", per_cu); grid = -1; return; }
        grid = cus;
    }
    if (grid < 0) return;
    Params p{};
    p.x = (const float*)d_in[0]; p.g_mix = (const float*)d_in[1]; p.w_in = (const float*)d_in[2]; p.g_sgu = (const float*)d_in[3]; p.sgu_w = (const float*)d_in[4];
    p.sgu_b = (const float*)d_in[5]; p.w_a = (const float*)d_in[6]; p.w_b = (const float*)d_in[7]; p.w_out = (const float*)d_in[8]; p.g_ffn = (const float*)d_in[9];
    p.wq = (const float*)d_in[10]; p.subk = (const float*)d_in[11]; p.ut = (const float*)d_in[12]; p.vt = (const float*)d_in[13]; p.g_fin = (const float*)d_in[14];
    p.out = (float*)d_out; p.ws = (unsigned char*)d_ws;
    (void)hipMemsetAsync((char*)d_ws + WS_CTL, 0, CTL_ZERO_BYTES, stream);
#ifndef MK_SPLIT
    p.lo = 0; p.hi = 11;
    void* args[] = {&p};
    hipError_t e = hipLaunchCooperativeKernel((const void*)fwd_mega, dim3(grid), dim3(NTHR), args, LDS_BYTES, stream);
    if (e != hipSuccess) fprintf(stderr, "kernel_launch: cooperative launch failed: %s (grid %d)\n", hipGetErrorString(e), grid);
#else
    #ifndef PHASE_SEQ
#define PHASE_SEQ {0, 1, 2, 3, 4, 5, 6, 7, 8, 9, 10}
#endif
    { const int seq[] = PHASE_SEQ; for (int k : seq) { p.lo = k; p.hi = k + 1; hipLaunchKernelGGL(fwd_mega, dim3(grid), dim3(NTHR), LDS_BYTES, stream, p); } }
#endif
}
```
